# Optimizing an MI355X kernel written in HIP

```python
import math
import jax, jax.numpy as jnp
from jax import lax
import numpy as np

D_MODEL = 2048
BATCH = 8
SEQ = 2048
DEPTH = 1

MIX_WIDTH = D_MODEL
GDN_WIDTH = MIX_WIDTH // 2
POOL_WIDTH = MIX_WIDTH - GDN_WIDTH
GDN_HEAD_DIM = 128
GDN_HEADS = GDN_WIDTH // GDN_HEAD_DIM
CONV_K = 4
CHUNK = 64
POOL_WINDOWS = (2, 4, 8, 16)
POOL_GROUPS = len(POOL_WINDOWS)
POOL_GROUP_DIM = POOL_WIDTH // POOL_GROUPS
MEM_LEN = 256
XATTN_HEADS = 4
XATTN_HEAD_DIM = D_MODEL // XATTN_HEADS
D_FF = 4 * D_MODEL
IN_COLS = 4 * GDN_WIDTH + 2 * GDN_HEADS + POOL_WIDTH
DEEPNORM_ALPHA = (2.0 * DEPTH) ** 0.25
DEEPNORM_BETA = (8.0 * DEPTH) ** -0.25
LN_EPS = 1e-5
NORM_EPS = 1e-6

kernel_name = "hybrid_gdn_pool_deepnorm_layer"


def layer_norm(x, g, b):
    xf = x.astype(jnp.float32)
    mu = jnp.mean(xf, axis=-1, keepdims=True)
    xc = xf - mu
    var = jnp.mean(xc * xc, axis=-1, keepdims=True)
    y = xc * lax.rsqrt(var + LN_EPS) * g.astype(jnp.float32) + b.astype(jnp.float32)
    return y.astype(x.dtype)


def l2norm(x):
    return x * lax.rsqrt(jnp.sum(x * x, axis=-1, keepdims=True) + NORM_EPS)


def causal_dwconv(x, w):
    c = x.shape[-1]
    return lax.conv_general_dilated(
        x, w.astype(x.dtype)[:, None, :], window_strides=(1,), padding=[(CONV_K - 1, 0)],
        dimension_numbers=("NWC", "WIO", "NWC"), feature_group_count=c)


def chunk_gated_delta_rule(q, k, v, g, beta):
    bsz, t_len, h, dk = q.shape
    dv = v.shape[-1]
    n = t_len // CHUNK

    def to_chunks(u):
        return u.reshape(bsz, n, CHUNK, h, u.shape[-1]).transpose(1, 0, 3, 2, 4)

    q = to_chunks(q * (dk ** -0.5))
    k = to_chunks(k)
    v = to_chunks(v)
    g = g.reshape(bsz, n, CHUNK, h).transpose(1, 0, 3, 2)
    beta = beta.reshape(bsz, n, CHUNK, h).transpose(1, 0, 3, 2)
    g = jnp.cumsum(g, axis=-1)

    idx = jnp.arange(CHUNK)
    lower_incl = idx[:, None] >= idx[None, :]
    strict = idx[:, None] > idx[None, :]
    diff = g[..., :, None] - g[..., None, :]
    decay = jnp.where(lower_incl, jnp.exp(jnp.where(lower_incl, diff, 0.0)), 0.0)

    k_beta = k * beta[..., None]
    v_beta = v * beta[..., None]
    L = jnp.where(strict, jnp.einsum("nbhcd,nbhmd->nbhcm", k_beta, k) * decay, 0.0)
    eye = jnp.eye(CHUNK, dtype=jnp.float32)
    rhs = jnp.concatenate([v_beta, k_beta * jnp.exp(g)[..., None]], axis=-1)
    sol = lax.linalg.triangular_solve(eye + L, rhs, left_side=True, lower=True, unit_diagonal=True)
    u, w = sol[..., :dv], sol[..., dv:]
    attn_intra = jnp.where(lower_incl, jnp.einsum("nbhcd,nbhmd->nbhcm", q, k) * decay, 0.0)

    def step(state, inp):
        q_c, k_c, u_c, w_c, g_c, a_c = inp
        v_new = u_c - jnp.einsum("bhck,bhkv->bhcv", w_c, state)
        o = (jnp.einsum("bhck,bhkv->bhcv", q_c * jnp.exp(g_c)[..., None], state)
             + jnp.einsum("bhcm,bhmv->bhcv", a_c, v_new))
        g_last = g_c[..., -1]
        k_dec = k_c * jnp.exp(g_last[..., None] - g_c)[..., None]
        state = state * jnp.exp(g_last)[..., None, None] + jnp.einsum("bhck,bhcv->bhkv", k_dec, v_new)
        return state, o

    s0 = jnp.zeros((bsz, h, dk, dv), jnp.float32)
    _, o = lax.scan(step, s0, (q, k, u, w, g, attn_intra))
    return o.transpose(1, 0, 3, 2, 4).reshape(bsz, t_len, h, dv)


def gated_deltanet(qkv, z, b, a, conv_w, a_log, dt_bias, norm_w):
    bsz, t_len, _ = qkv.shape
    qkv = jax.nn.silu(causal_dwconv(qkv, conv_w)).astype(jnp.float32)
    q, k, v = jnp.split(qkv, 3, axis=-1)
    shp = (bsz, t_len, GDN_HEADS, GDN_HEAD_DIM)
    q = l2norm(q.reshape(shp))
    k = l2norm(k.reshape(shp))
    v = v.reshape(shp)
    beta = jax.nn.sigmoid(b.astype(jnp.float32))
    g = -jnp.exp(a_log.astype(jnp.float32)) * jax.nn.softplus(
        a.astype(jnp.float32) + dt_bias.astype(jnp.float32))
    o = chunk_gated_delta_rule(q, k, v, g, beta)
    o = o * lax.rsqrt(jnp.mean(o * o, axis=-1, keepdims=True) + NORM_EPS) * norm_w.astype(jnp.float32)
    o = o * jax.nn.silu(z.astype(jnp.float32).reshape(shp))
    return o.reshape(bsz, t_len, GDN_WIDTH).astype(z.dtype)


def multiscale_pool(p, pool_w, pool_scale):
    bsz, t_len, _ = p.shape
    pg = p.astype(jnp.float32).reshape(bsz, t_len, POOL_GROUPS, POOL_GROUP_DIM)
    cs = jnp.cumsum(pg, axis=1)
    pos = jnp.arange(t_len)
    means = []
    for gi, win in enumerate(POOL_WINDOWS):
        c = cs[:, :, gi]
        lag = jnp.pad(c[:, : t_len - win], ((0, 0), (win, 0), (0, 0)))
        cnt = jnp.minimum(pos + 1, win).astype(jnp.float32)[None, :, None]
        means.append((c - lag) / cnt)
    pooled = jnp.stack(means, axis=2) - pg
    mixed = jnp.einsum("btgc,gcd->btgd", pooled.astype(p.dtype), pool_w)
    return mixed.reshape(bsz, t_len, POOL_WIDTH) * pool_scale


def memory_cross_attention(h, mem, wq, wk, wv, wo):
    bsz, t_len, _ = h.shape
    q = (h @ wq).reshape(bsz, t_len, XATTN_HEADS, XATTN_HEAD_DIM)
    k = (mem @ wk).reshape(bsz, mem.shape[1], XATTN_HEADS, XATTN_HEAD_DIM)
    v = (mem @ wv).reshape(bsz, mem.shape[1], XATTN_HEADS, XATTN_HEAD_DIM)
    s = jnp.einsum("bqhd,bmhd->bhqm", q, k).astype(jnp.float32) * (XATTN_HEAD_DIM ** -0.5)
    p = jax.nn.softmax(s, axis=-1).astype(v.dtype)
    o = jnp.einsum("bhqm,bmhd->bqhd", p, v).reshape(bsz, t_len, D_MODEL)
    return o @ wo


def setup_inputs(seed: int = 0) -> dict:
    key = jax.random.key(seed)
    ks = jax.random.split(key, 24)
    f32 = jnp.float32
    nrm = lambda k, shape, scale: jax.random.normal(k, shape, f32) * scale
    x = nrm(ks[0], (BATCH, SEQ, D_MODEL), 1.0)
    mem = nrm(ks[1], (BATCH, MEM_LEN, D_MODEL), 1.0)
    w_in = nrm(ks[2], (DEPTH, D_MODEL, IN_COLS), D_MODEL ** -0.5)
    conv_w = nrm(ks[3], (DEPTH, CONV_K, 3 * GDN_WIDTH), CONV_K ** -0.5)
    a_log = jnp.log(jax.random.uniform(ks[4], (DEPTH, GDN_HEADS), f32, 1.0, 16.0))
    dt = jnp.exp(jax.random.uniform(ks[5], (DEPTH, GDN_HEADS), f32, math.log(1e-3), math.log(1e-1)))
    dt_bias = dt + jnp.log(-jnp.expm1(-dt))
    gdn_norm_w = 1.0 + nrm(ks[6], (DEPTH, GDN_HEAD_DIM), 0.02)
    pool_w = nrm(ks[7], (DEPTH, POOL_GROUPS, POOL_GROUP_DIM, POOL_GROUP_DIM), POOL_GROUP_DIM ** -0.5)
    pool_scale = 1.0 + nrm(ks[8], (DEPTH, POOL_WIDTH), 0.1)
    w_out = nrm(ks[9], (DEPTH, MIX_WIDTH, D_MODEL), MIX_WIDTH ** -0.5 * DEEPNORM_BETA)
    ln1_g = 1.0 + nrm(ks[10], (DEPTH, D_MODEL), 0.02)
    ln1_b = nrm(ks[11], (DEPTH, D_MODEL), 0.02)
    xq_w = nrm(ks[12], (DEPTH, D_MODEL, D_MODEL), D_MODEL ** -0.5)
    xk_w = nrm(ks[13], (DEPTH, D_MODEL, D_MODEL), D_MODEL ** -0.5)
    xv_w = nrm(ks[14], (DEPTH, D_MODEL, D_MODEL), D_MODEL ** -0.5)
    xo_w = nrm(ks[15], (DEPTH, D_MODEL, D_MODEL), D_MODEL ** -0.5 * DEEPNORM_BETA)
    ln2_g = 1.0 + nrm(ks[16], (DEPTH, D_MODEL), 0.02)
    ln2_b = nrm(ks[17], (DEPTH, D_MODEL), 0.02)
    w_up = nrm(ks[18], (DEPTH, D_MODEL, D_FF), D_MODEL ** -0.5)
    w_down = nrm(ks[19], (DEPTH, D_FF, D_MODEL), D_FF ** -0.5 * DEEPNORM_BETA)
    ln3_g = 1.0 + nrm(ks[20], (DEPTH, D_MODEL), 0.02)
    ln3_b = nrm(ks[21], (DEPTH, D_MODEL), 0.02)
    return {"x": x, "mem": mem, "w_in": w_in, "conv_w": conv_w, "a_log": a_log, "dt_bias": dt_bias,
            "gdn_norm_w": gdn_norm_w, "pool_w": pool_w, "pool_scale": pool_scale, "w_out": w_out,
            "ln1_g": ln1_g, "ln1_b": ln1_b, "xq_w": xq_w, "xk_w": xk_w, "xv_w": xv_w, "xo_w": xo_w,
            "ln2_g": ln2_g, "ln2_b": ln2_b, "w_up": w_up, "w_down": w_down, "ln3_g": ln3_g, "ln3_b": ln3_b}


def reference(x, mem, w_in, conv_w, a_log, dt_bias, gdn_norm_w, pool_w, pool_scale, w_out,
              ln1_g, ln1_b, xq_w, xk_w, xv_w, xo_w, ln2_g, ln2_b, w_up, w_down, ln3_g, ln3_b):
    W, H = GDN_WIDTH, GDN_HEADS
    h = x
    for l in range(DEPTH):
        proj = h @ w_in[l]
        qkv = proj[..., : 3 * W]
        z = proj[..., 3 * W: 4 * W]
        b = proj[..., 4 * W: 4 * W + H]
        a = proj[..., 4 * W + H: 4 * W + 2 * H]
        p = proj[..., 4 * W + 2 * H:]
        o_gdn = gated_deltanet(qkv, z, b, a, conv_w[l], a_log[l], dt_bias[l], gdn_norm_w[l])
        o_pool = multiscale_pool(p, pool_w[l], pool_scale[l])
        mix = jnp.concatenate([o_gdn, o_pool], axis=-1) @ w_out[l]
        h = layer_norm(DEEPNORM_ALPHA * h + mix, ln1_g[l], ln1_b[l])
        xa = memory_cross_attention(h, mem, xq_w[l], xk_w[l], xv_w[l], xo_w[l])
        h = layer_norm(DEEPNORM_ALPHA * h + xa, ln2_g[l], ln2_b[l])
        ff = jnp.square(jax.nn.relu(h @ w_up[l])) @ w_down[l]
        h = layer_norm(DEEPNORM_ALPHA * h + ff, ln3_g[l], ln3_b[l])
    return h
```

```cpp
#include <hip/hip_runtime.h>
#include <hip/hip_cooperative_groups.h>
#include <cstdio>
#include <cstdint>
namespace cg = cooperative_groups;

#define LAS __attribute__((address_space(3)))
typedef unsigned short bf16_t;
typedef short bf16x8 __attribute__((ext_vector_type(8)));
typedef float f32x4 __attribute__((ext_vector_type(4)));
typedef float f32x2 __attribute__((ext_vector_type(2)));
typedef unsigned u32x4 __attribute__((ext_vector_type(4)));
typedef unsigned u32x2 __attribute__((ext_vector_type(2)));

constexpr int M_TOK = 16384, DM = 2048, SEQ = 2048, NBATCH = 8, DFF = 8192;
constexpr int W_INLD = 5136;
constexpr int NCHUNK = 32;
constexpr float ALPHA = 1.189207115002721f;
constexpr float LN_EPS = 1e-5f, NORM_EPS = 1e-6f;
constexpr size_t MiB = 1024ull * 1024ull;
constexpr size_t WS_WUP = 0, WS_WDN = 32 * MiB, WS_WIN = 64 * MiB, WS_WOUT = 84 * MiB, WS_WQ = 92 * MiB, WS_WK = 100 * MiB,
                 WS_WV = 108 * MiB, WS_WO = 116 * MiB, WS_WPOOL = 124 * MiB, WS_WBA = 124 * MiB + 512 * 1024, WS_BA = 125 * MiB,
                 WS_STATS = 126 * MiB, WS_GL = 126 * MiB + 512 * 1024;
constexpr size_t WS_MEMB = 128 * MiB, WS_XB = 136 * MiB, WS_POOLED = 136 * MiB, WS_HB = 136 * MiB;
constexpr size_t WS_QKV = 200 * MiB, WS_Z = 296 * MiB, WS_P = 328 * MiB;
constexpr size_t WS_W = 360 * MiB, WS_QG = 392 * MiB, WS_KDT = 424 * MiB, WS_AI = 456 * MiB, WS_UT = 472 * MiB;
constexpr size_t WS_MIX = 200 * MiB, WS_KX = 264 * MiB, WS_VX = 272 * MiB;
constexpr size_t WS_G = 296 * MiB, WS_VOT = 328 * MiB;
constexpr size_t WS_Q = 296 * MiB, WS_PR = 200 * MiB, WS_O = 296 * MiB, WS_HID = 200 * MiB;
constexpr size_t WS_XCH = 504 * MiB;
constexpr size_t WS_END = 506 * MiB;
constexpr size_t WS_CTL = 127 * MiB; constexpr size_t CTL_BYTES = 81920;
constexpr size_t WS_FLAGS = WS_CTL + 65536;
constexpr int LATE0 = 28;
constexpr int LDS_BYTES = 144 * 1024;

#define LDS_BARRIER() do { asm volatile("s_waitcnt lgkmcnt(0)" ::: "memory"); __builtin_amdgcn_s_barrier(); asm volatile("" ::: "memory"); } while (0)
__device__ __forceinline__ float bf2f(unsigned h) { return __uint_as_float(h << 16); }
typedef __bf16 bf16x2_t __attribute__((ext_vector_type(2)));
__device__ __forceinline__ unsigned cvt_pk_bf16(float lo, float hi) { const f32x2 v = {lo, hi}; const bf16x2_t r = __builtin_convertvector(v, bf16x2_t); return __builtin_bit_cast(unsigned, r); }
template <int CTRL> __device__ __forceinline__ float dpp_mov(float v) { return __builtin_bit_cast(float, __builtin_amdgcn_update_dpp(0, __builtin_bit_cast(int, v), CTRL, 0xf, 0xf, true)); }
__device__ __forceinline__ float row16_sum(float v) { v += dpp_mov<0xB1>(v); v += dpp_mov<0x4E>(v); v += dpp_mov<0x141>(v); v += dpp_mov<0x140>(v); return v; }
__device__ __forceinline__ float silu_f(float x) { return x * __builtin_amdgcn_rcpf(1.0f + __expf(-x)); }

namespace pg8 {
constexpr int BM = 256, BK = 64, HALF = 128, HTB = HALF * BK * 2, STAGE_BYTES = 8 * HTB, NXCD = 8, WGM = 8;
__device__ __forceinline__ int lds_byte(int r, int c) { const int st = (r >> 4) * 2 + (c >> 5), rr = r & 15, cc = c & 31, ob = rr * 64 + cc * 2; return st * 1024 + (ob ^ (((ob >> 9) & 1) << 5)); }
__device__ __forceinline__ void stage_rc(int b, int& R, int& C) { const int st = b / 1024, sb = b % 1024, swz = sb ^ (((sb >> 9) & 1) << 5); R = (st >> 1) * 16 + swz / 64; C = (st & 1) * 32 + (swz % 64) / 2; }
__device__ __forceinline__ int perm32(int rho) { const int n = rho >> 4, i = rho & 15; return 8 * (i >> 2) + 4 * n + (i & 3); }

struct Unit { int pm, pn, z0, z1; };
struct Gemm {
    const bf16_t* A; const bf16_t* Bt; int lda, ldb, K; long a_z0, a_z1, b_z0, b_z1;
    __device__ __forceinline__ const char* a_ptr(const Unit& u) const { return (const char*)(A + u.z0 * a_z0 + u.z1 * a_z1 + (long)u.pm * BM * lda); }
    __device__ __forceinline__ const char* b_ptr(const Unit& u) const { return (const char*)(Bt + u.z0 * b_z0 + u.z1 * b_z1 + (long)u.pn * BM * ldb); }
};
struct Order {
    int nM, nN, nZ1, per, total, G, c;
    __device__ __forceinline__ void init(int nM_, int nN_, int nZ0_, int nZ1_, int G_, int c_) { nM = nM_; nN = nN_; nZ1 = nZ1_; per = nM * nN; total = per * nZ0_ * nZ1_; G = G_; c = c_; }
    __device__ __forceinline__ bool next(int i, Unit& u) const {
        const long L = (long)i * G + c; if (c < 0 || L >= total) return false;
        if (total == per) {
            int wgid = (int)L; { const int nwg = per, q = nwg / NXCD, r = nwg % NXCD, xcd = wgid % NXCD, off = wgid / NXCD; wgid = (xcd < r ? xcd * (q + 1) : r * (q + 1) + (xcd - r) * q) + off; }
            const int nig = WGM * nN, gid = wgid / nig, fm = gid * WGM, gsz = (nM - fm) < WGM ? (nM - fm) : WGM;
            u.pm = fm + ((wgid % nig) % gsz); u.pn = (wgid % nig) / gsz; u.z0 = 0; u.z1 = 0;
        } else {
            const int zb = (int)(L / per), w = (int)(L % per);
            u.pm = w % nM; u.pn = w / nM; u.z0 = zb / nZ1; u.z1 = zb % nZ1;
        }
        return true;
    }
};

struct MapPlain { bf16_t* O; int ldc;
    __device__ __forceinline__ void get(const Unit& u, bf16_t*& p, int& ld) const { p = O + (size_t)u.pm * BM * ldc + u.pn * BM; ld = ldc; } };
struct MapG1 { bf16_t *qkv, *z, *pp;
    __device__ __forceinline__ void get(const Unit& u, bf16_t*& p, int& ld) const {
        const int colt = u.pn * BM; const size_t row0 = (size_t)u.pm * BM;
        if (colt < 3072) { p = qkv + row0 * 3072 + colt; ld = 3072; } else if (colt < 4096) { p = z + row0 * 1024 + (colt - 3072); ld = 1024; } else { p = pp + row0 * 1024 + (colt - 4096); ld = 1024; } } };
struct MapPool { bf16_t* mix;
    __device__ __forceinline__ void get(const Unit& u, bf16_t*& p, int& ld) const { p = mix + (size_t)u.pm * BM * 2048 + 1024 + u.z1 * 256; ld = 2048; } };
struct MapG { bf16_t* g;
    __device__ __forceinline__ void get(const Unit& u, bf16_t*& p, int& ld) const { p = g + ((size_t)(u.z0 * 4 + u.z1) * 256) * 2048 + u.pn * BM; ld = 2048; } };
struct MapVOT { bf16_t* v;
    __device__ __forceinline__ void get(const Unit& u, bf16_t*& p, int& ld) const { p = v + ((size_t)u.z0 * 2048 + (size_t)u.pm * BM) * 1024 + u.z1 * 256; ld = 1024; } };
struct MapO { bf16_t* o;
    __device__ __forceinline__ void get(const Unit& u, bf16_t*& p, int& ld) const { p = o + ((size_t)u.z0 * 2048 + (size_t)u.pm * BM) * 2048 + u.z1 * 512 + u.pn * BM; ld = 2048; } };

template <int ACT  , class Map, bool SCALED = false> struct EpiBf16 {
    static constexpr bool PERM = true, AFTER_DRAIN = false, FUSED2 = false;
    Map map; float scale;
    __device__ __forceinline__ void operator()(const f32x4 (&acc)[2][2][4][2], const Unit& u, int wr, int wc, int fr, int fq) const {
        bf16_t* base; int ldc; map.get(u, base, ldc);
        const int row0 = wr * 64 + fr, col0 = wc * 32 + 8 * fq;
#pragma unroll
        for (int ai = 0; ai < 2; ++ai)
#pragma unroll
            for (int m = 0; m < 4; ++m) { bf16_t* rowp = base + (size_t)(row0 + ai * HALF + m * 16) * ldc + col0;
#pragma unroll
                for (int bj = 0; bj < 2; ++bj) { f32x4 v0 = acc[ai][bj][m][0], v1 = acc[ai][bj][m][1];
                    if (ACT == 2) {
#pragma unroll
                        for (int j = 0; j < 4; ++j) { const float a = fmaxf(v0[j], 0.f), b = fmaxf(v1[j], 0.f); v0[j] = a * a; v1[j] = b * b; } }
                    if (SCALED) { v0 = v0 * scale; v1 = v1 * scale; }
                    u32x4 w; w.x = cvt_pk_bf16(v0[0], v0[1]); w.y = cvt_pk_bf16(v0[2], v0[3]); w.z = cvt_pk_bf16(v1[0], v1[1]); w.w = cvt_pk_bf16(v1[2], v1[3]);
                    *(u32x4*)(rowp + bj * HALF) = w; } }
    }
};
template <bool LN> struct EpiResid {
    static constexpr bool PERM = false, AFTER_DRAIN = false, FUSED2 = false;
    float* out; const float* base; const float* stats; const float* g; const float* b;
    __device__ __forceinline__ void operator()(const f32x4 (&acc)[2][2][4][2], const Unit& u, int wr, int wc, int fr, int fq) const {
        const int col0 = u.pn * BM + wc * 32 + 4 * fq;
#pragma unroll
        for (int ai = 0; ai < 2; ++ai)
#pragma unroll
            for (int m = 0; m < 4; ++m) { const int r = u.pm * BM + ai * HALF + wr * 64 + m * 16 + fr; const size_t off = (size_t)r * DM + col0;
                f32x2 st = (f32x2){0.f, 1.f}; if (LN) st = *(const f32x2*)(stats + 2 * (size_t)r);
#pragma unroll
                for (int bj = 0; bj < 2; ++bj)
#pragma unroll
                    for (int n = 0; n < 2; ++n) { f32x4 rs = *(const f32x4*)((LN ? (const float*)out : base) + off + bj * HALF + n * 16);
                        if (LN) { const f32x4 gv = *(const f32x4*)(g + col0 + bj * HALF + n * 16), bv = *(const f32x4*)(b + col0 + bj * HALF + n * 16); rs = (rs - st.x) * st.y * gv + bv; }
                        *(f32x4*)(out + off + bj * HALF + n * 16) = rs * ALPHA + acc[ai][bj][m][n]; }
                asm volatile("" ::: "memory");
            }
    }
};
template <bool FROMX> struct EpiStream {
    static constexpr bool PERM = true, AFTER_DRAIN = false, FUSED2 = false;
    bf16_t* S; const float* x;
    __device__ __forceinline__ void operator()(const f32x4 (&acc)[2][2][4][2], const Unit& u, int wr, int wc, int fr, int fq) const {
        const int col0 = u.pn * BM + wc * 32 + 8 * fq;
#pragma unroll
        for (int ai = 0; ai < 2; ++ai)
#pragma unroll
            for (int m = 0; m < 4; ++m) { const size_t off = (size_t)(u.z0 * 2048 + u.pm * BM + ai * HALF + wr * 64 + m * 16 + fr) * DM + col0;
#pragma unroll
                for (int bj = 0; bj < 2; ++bj) { f32x4 r0, r1;
                    if (FROMX) { r0 = *(const f32x4*)(x + off + bj * HALF); r1 = *(const f32x4*)(x + off + bj * HALF + 4); }
                    else { const u32x4 raw = *(const u32x4*)(S + off + bj * HALF);
                        r0 = (f32x4){__uint_as_float(raw.x << 16), __uint_as_float(raw.x & 0xffff0000u), __uint_as_float(raw.y << 16), __uint_as_float(raw.y & 0xffff0000u)};
                        r1 = (f32x4){__uint_as_float(raw.z << 16), __uint_as_float(raw.z & 0xffff0000u), __uint_as_float(raw.w << 16), __uint_as_float(raw.w & 0xffff0000u)}; }
                    const f32x4 v0 = r0 * ALPHA + acc[ai][bj][m][0], v1 = r1 * ALPHA + acc[ai][bj][m][1];
                    u32x4 w; w.x = cvt_pk_bf16(v0[0], v0[1]); w.y = cvt_pk_bf16(v0[2], v0[3]); w.z = cvt_pk_bf16(v1[0], v1[1]); w.w = cvt_pk_bf16(v1[2], v1[3]);
                    *(u32x4*)(S + off + bj * HALF) = w; }
                asm volatile("" ::: "memory"); }
    }
};
struct EpiSoftmax {
    static constexpr bool PERM = true, AFTER_DRAIN = true, FUSED2 = false;
    bf16_t* P; float scale_log2;
    __device__ __forceinline__ void fused(f32x4 (&acc)[2][2][4][2], const Unit& u, int wr, int wc, int fr, int fq, LAS unsigned char* lds, int wid, int lane) const {
        LAS f32x2* X = (LAS f32x2*)lds;
        float mxs[2][4];
#pragma unroll
        for (int ai = 0; ai < 2; ++ai)
#pragma unroll
            for (int m = 0; m < 4; ++m) {
                float mx = -3.0e38f;
#pragma unroll
                for (int bj = 0; bj < 2; ++bj)
#pragma unroll
                    for (int n = 0; n < 2; ++n) { f32x4 v = acc[ai][bj][m][n] * scale_log2; acc[ai][bj][m][n] = v; mx = fmaxf(mx, fmaxf(fmaxf(v[0], v[1]), fmaxf(v[2], v[3]))); }
                mx = fmaxf(mx, __shfl_xor(mx, 16)); mx = fmaxf(mx, __shfl_xor(mx, 32));
                float s = 0.f;
#pragma unroll
                for (int bj = 0; bj < 2; ++bj)
#pragma unroll
                    for (int n = 0; n < 2; ++n) { f32x4 v = acc[ai][bj][m][n];
#pragma unroll
                        for (int j = 0; j < 4; ++j) { v[j] = __builtin_amdgcn_exp2f(v[j] - mx); s += v[j]; }
                        acc[ai][bj][m][n] = v; }
                s += __shfl_xor(s, 16); s += __shfl_xor(s, 32);
                mxs[ai][m] = mx;
                if (fq == 0) X[(ai * HALF + wr * 64 + m * 16 + fr) * 4 + wc] = (f32x2){mx, s};
            }
        asm volatile("s_waitcnt lgkmcnt(0)" ::: "memory"); __builtin_amdgcn_s_barrier(); asm volatile("" ::: "memory");
        const size_t rowg = (size_t)u.z0 * 2048 + (size_t)u.pm * BM;
#pragma unroll
        for (int ai = 0; ai < 2; ++ai)
#pragma unroll
            for (int m = 0; m < 4; ++m) { const int r = ai * HALF + wr * 64 + m * 16 + fr;
                const f32x2 a = X[r * 4 + 0], b = X[r * 4 + 1], c = X[r * 4 + 2], d = X[r * 4 + 3];
                const float mt = fmaxf(fmaxf(a.x, b.x), fmaxf(c.x, d.x));
                const float S = a.y * __builtin_amdgcn_exp2f(a.x - mt) + b.y * __builtin_amdgcn_exp2f(b.x - mt) + c.y * __builtin_amdgcn_exp2f(c.x - mt) + d.y * __builtin_amdgcn_exp2f(d.x - mt);
                const float f = __builtin_amdgcn_exp2f(mxs[ai][m] - mt) / S;
                bf16_t* rowp = P + (rowg + r) * 1024 + u.z1 * 256 + wc * 32 + 8 * fq;
#pragma unroll
                for (int bj = 0; bj < 2; ++bj) { const f32x4 v0 = acc[ai][bj][m][0] * f, v1 = acc[ai][bj][m][1] * f;
                    u32x4 w; w.x = cvt_pk_bf16(v0[0], v0[1]); w.y = cvt_pk_bf16(v0[2], v0[3]); w.z = cvt_pk_bf16(v1[0], v1[1]); w.w = cvt_pk_bf16(v1[2], v1[3]);
                    *(u32x4*)(rowp + bj * HALF) = w; } }
    }
};

struct GemmAB { Gemm g0, g1; int lda, ldb, K;
    __device__ __forceinline__ const char* a_ptr(const Unit& u) const { if (u.z0 < 8) return g0.a_ptr(u); Unit t = u; t.z0 -= 8; return g1.a_ptr(t); }
    __device__ __forceinline__ const char* b_ptr(const Unit& u) const { if (u.z0 < 8) return g0.b_ptr(u); Unit t = u; t.z0 -= 8; return g1.b_ptr(t); } };
struct ABOrder { int bid;
    __device__ __forceinline__ bool next(int i, Unit& u) const { if (i > 1) return false; const int zb = bid >> 3, w = bid & 7; u.z1 = zb & 3;
        if (i == 0) { u.pm = 0; u.pn = w; u.z0 = zb >> 2; } else { u.pm = w; u.pn = 0; u.z0 = (zb >> 2) + 8; } return true; } };
struct MapAB { bf16_t* g; bf16_t* v;
    __device__ __forceinline__ void get(const Unit& u, bf16_t*& p, int& ld) const { if (u.z0 < 8) MapG{g}.get(u, p, ld); else { Unit t = u; t.z0 -= 8; MapVOT{v}.get(t, p, ld); } } };
struct PanelOrder {
    int gp, q; bool ok;
    __device__ __forceinline__ void init(int G, int bid) { ok = (G == 256); const int vc = (bid & 7) * 32 + (bid >> 3); gp = vc >> 2; q = vc & 3; }
    __device__ __forceinline__ bool next(int i, Unit& u) const { if (!ok || i > 1) return false; u.z0 = gp >> 3; u.pm = gp & 7; u.pn = 2 * q + i; u.z1 = 0; return true; }
};
template <bool FROMX, bool FINAL> struct EpiLn2 {
    static constexpr bool PERM = true, AFTER_DRAIN = false, FUSED2 = true;
    bf16_t* S; const float* x; float* outf; const float* g; const float* b; unsigned long long* slots; unsigned* cnt;
    __device__ __forceinline__ void values_stats(f32x4 (&acc)[2][2][4][2], const Unit& u, int wr, int wc, int fr, int fq, LAS f32x2* P1) const {
        const int col0 = u.pn * BM + wc * 32 + 8 * fq;
#pragma unroll
        for (int ai = 0; ai < 2; ++ai)
#pragma unroll
            for (int m = 0; m < 4; ++m) { const int rl = ai * HALF + wr * 64 + m * 16 + fr; const size_t off = (size_t)(u.z0 * 2048 + u.pm * BM + rl) * DM + col0;
                float s1 = 0.f, s2 = 0.f;
#pragma unroll
                for (int bj = 0; bj < 2; ++bj) { f32x4 r0, r1;
                    if (FROMX) { r0 = *(const f32x4*)(x + off + bj * HALF); r1 = *(const f32x4*)(x + off + bj * HALF + 4); }
                    else { const u32x4 raw = *(const u32x4*)(S + off + bj * HALF);
                        r0 = (f32x4){__uint_as_float(raw.x << 16), __uint_as_float(raw.x & 0xffff0000u), __uint_as_float(raw.y << 16), __uint_as_float(raw.y & 0xffff0000u)};
                        r1 = (f32x4){__uint_as_float(raw.z << 16), __uint_as_float(raw.z & 0xffff0000u), __uint_as_float(raw.w << 16), __uint_as_float(raw.w & 0xffff0000u)}; }
                    const f32x4 v0 = r0 * ALPHA + acc[ai][bj][m][0], v1 = r1 * ALPHA + acc[ai][bj][m][1];
                    acc[ai][bj][m][0] = v0; acc[ai][bj][m][1] = v1;
                    s1 += ((v0[0] + v0[1]) + (v0[2] + v0[3])) + ((v1[0] + v1[1]) + (v1[2] + v1[3]));
                    s2 += ((v0[0] * v0[0] + v0[1] * v0[1]) + (v0[2] * v0[2] + v0[3] * v0[3])) + ((v1[0] * v1[0] + v1[1] * v1[1]) + (v1[2] * v1[2] + v1[3] * v1[3]));
                    asm volatile("" ::: "memory"); }
                s1 += __shfl_xor(s1, 16); s1 += __shfl_xor(s1, 32); s2 += __shfl_xor(s2, 16); s2 += __shfl_xor(s2, 32);
                if (fq == 0) P1[rl * 4 + wc] = (f32x2){s1, s2};
                asm volatile("" ::: "memory"); }
    }
    __device__ __forceinline__ void first(f32x4 (&acc)[2][2][4][2], const Unit& u, int wr, int wc, int fr, int fq, LAS unsigned char* ldsx, int tid) const {
        LAS f32x2* P1 = (LAS f32x2*)ldsx; LAS f32x2* T0 = (LAS f32x2*)(ldsx + 8192);
        values_stats(acc, u, wr, wc, fr, fq, P1);
        const int col0 = u.pn * BM + wc * 32 + 8 * fq;
#pragma unroll
        for (int ai = 0; ai < 2; ++ai)
#pragma unroll
            for (int m = 0; m < 4; ++m) { const size_t off = (size_t)(u.z0 * 2048 + u.pm * BM + ai * HALF + wr * 64 + m * 16 + fr) * DM + col0;
#pragma unroll
                for (int bj = 0; bj < 2; ++bj) { const f32x4 v0 = acc[ai][bj][m][0], v1 = acc[ai][bj][m][1];
                    u32x4 w; w.x = cvt_pk_bf16(v0[0], v0[1]); w.y = cvt_pk_bf16(v0[2], v0[3]); w.z = cvt_pk_bf16(v1[0], v1[1]); w.w = cvt_pk_bf16(v1[2], v1[3]);
                    *(u32x4*)(S + off + bj * HALF) = w; } }
        LDS_BARRIER();
        if (tid < 256) { const f32x2 a = P1[tid * 4 + 0], b2 = P1[tid * 4 + 1], c = P1[tid * 4 + 2], d = P1[tid * 4 + 3]; T0[tid] = (f32x2){(a.x + b2.x) + (c.x + d.x), (a.y + b2.y) + (c.y + d.y)}; }
        LDS_BARRIER();
    }
    __device__ __forceinline__ void last(f32x4 (&acc)[2][2][4][2], const Unit& u, int wr, int wc, int fr, int fq, LAS unsigned char* ldsx, int tid, int lane, int wid) const {
        LAS f32x2* P1 = (LAS f32x2*)ldsx; LAS f32x2* T0 = (LAS f32x2*)(ldsx + 8192); LAS f32x2* ST = (LAS f32x2*)(ldsx + 10240);
        values_stats(acc, u, wr, wc, fr, fq, P1);
        LDS_BARRIER();
        const int gp = u.z0 * 8 + u.pm, q = u.pn >> 1;
        unsigned long long* slot = slots + ((size_t)gp * 256 + (tid & 255)) * 4;
        if (tid < 256) { const f32x2 a = P1[tid * 4 + 0], b2 = P1[tid * 4 + 1], c = P1[tid * 4 + 2], d = P1[tid * 4 + 3], t0 = T0[tid];
            const float s1 = t0.x + ((a.x + b2.x) + (c.x + d.x)), s2 = t0.y + ((a.y + b2.y) + (c.y + d.y));
            __hip_atomic_store(slot + q, ((unsigned long long)__float_as_uint(s2) << 32) | __float_as_uint(s1), __ATOMIC_RELAXED, __HIP_MEMORY_SCOPE_AGENT); }
        asm volatile("s_waitcnt vmcnt(0)" ::: "memory");
        if (wid < 4 && lane == 0) __hip_atomic_fetch_add(cnt + 64 * gp, 1u, __ATOMIC_RELAXED, __HIP_MEMORY_SCOPE_AGENT);
        if (wid == 0) { unsigned sp = 0u;
            while ((unsigned)__builtin_amdgcn_readfirstlane(__hip_atomic_load(cnt + 64 * gp, __ATOMIC_RELAXED, __HIP_MEMORY_SCOPE_AGENT)) < 16u) { __builtin_amdgcn_s_sleep(2); if (++sp > (1u << 22)) break; }
            __builtin_amdgcn_fence(__ATOMIC_ACQUIRE, "agent"); }
        asm volatile("s_waitcnt vmcnt(0) lgkmcnt(0)" ::: "memory"); __builtin_amdgcn_s_barrier(); asm volatile("" ::: "memory");
        if (tid < 256) { float s1 = 0.f, s2 = 0.f;
#pragma unroll
            for (int t = 0; t < 4; ++t) { const unsigned long long w = __hip_atomic_load(slot + t, __ATOMIC_RELAXED, __HIP_MEMORY_SCOPE_AGENT); s1 += __uint_as_float((unsigned)w); s2 += __uint_as_float((unsigned)(w >> 32)); }
            const float mean = s1 * (1.0f / DM); const float var = fmaxf(s2 * (1.0f / DM) - mean * mean, 0.f);
            ST[tid] = (f32x2){mean, 1.0f / sqrtf(var + LN_EPS)}; }
        LDS_BARRIER();
#pragma unroll
        for (int pass = 0; pass < 2; ++pass) {
            const int col0 = (u.pn - pass) * BM + wc * 32 + 8 * fq;
#pragma unroll
            for (int ai = 0; ai < 2; ++ai)
#pragma unroll
                for (int m = 0; m < 4; ++m) { const int rl = ai * HALF + wr * 64 + m * 16 + fr; const size_t off = (size_t)(u.z0 * 2048 + u.pm * BM + rl) * DM + col0; const f32x2 st = ST[rl];
#pragma unroll
                    for (int bj = 0; bj < 2; ++bj) { f32x4 v0, v1;
                        if (pass == 0) { v0 = acc[ai][bj][m][0]; v1 = acc[ai][bj][m][1]; }
                        else { const u32x4 raw = *(const u32x4*)(S + off + bj * HALF);
                            v0 = (f32x4){__uint_as_float(raw.x << 16), __uint_as_float(raw.x & 0xffff0000u), __uint_as_float(raw.y << 16), __uint_as_float(raw.y & 0xffff0000u)};
                            v1 = (f32x4){__uint_as_float(raw.z << 16), __uint_as_float(raw.z & 0xffff0000u), __uint_as_float(raw.w << 16), __uint_as_float(raw.w & 0xffff0000u)}; }
                        f32x4 o0, o1;
                        { const f32x4 g0 = *(const f32x4*)(g + col0 + bj * HALF), b0 = *(const f32x4*)(b + col0 + bj * HALF); o0 = (v0 - st.x) * st.y * g0 + b0; }
                        if (FINAL) { *(f32x4*)(outf + off + bj * HALF) = o0; asm volatile("" ::: "memory"); }
                        { const f32x4 g1 = *(const f32x4*)(g + col0 + bj * HALF + 4), b1 = *(const f32x4*)(b + col0 + bj * HALF + 4); o1 = (v1 - st.x) * st.y * g1 + b1; }
                        if (FINAL) { *(f32x4*)(outf + off + bj * HALF + 4) = o1; }
                        else { u32x4 w; w.x = cvt_pk_bf16(o0[0], o0[1]); w.y = cvt_pk_bf16(o0[2], o0[3]); w.z = cvt_pk_bf16(o1[0], o1[1]); w.w = cvt_pk_bf16(o1[2], o1[3]); *(u32x4*)(S + off + bj * HALF) = w; }
                        asm volatile("" ::: "memory"); }
                }
        }
    }
};

template <class Epi, bool ALIGN_EPI, class Sched = Order, class GemmT = Gemm>
__device__ __forceinline__ void gemm_phase(LAS unsigned char* lds, const GemmT g, const Sched& S, const Epi& E) {
    int tid = threadIdx.x; asm volatile("" : "+v"(tid));
    const int wid = __builtin_amdgcn_readfirstlane(tid >> 6), lane = tid & 63, wr = wid >> 2, wc = wid & 3, fr = lane & 15, fq = lane >> 4;
    int K_ = g.K; asm volatile("" : "+s"(K_));
    const int nt = K_ / BK;
    unsigned voffA[2], voffB[2];
#pragma unroll
    for (int i = 0; i < 2; ++i) { int R, C; stage_rc(tid * 16 + i * 8192, R, C); const int Rb = Epi::PERM ? ((R & ~31) + perm32(R & 31)) : R;
        voffA[i] = (unsigned)(R * g.lda + C) * 2u; voffB[i] = (unsigned)(Rb * g.ldb + C) * 2u; }
    const size_t kstep = (size_t)(BK * 2);
    const size_t hstepA = (size_t)HALF * g.lda * 2, hstepB = (size_t)HALF * g.ldb * 2;
    const unsigned ldsw = (unsigned)wid * 1024u;
    const int aoff = lds_byte(wr * 64 + fr, fq * 8), boff = lds_byte(wc * 32 + fr, fq * 8);
#define PG8_SA(b, h) (((b) * 2 + (h)) * HTB)
#define PG8_SB(b, h) ((4 + (b) * 2 + (h)) * HTB)
#define PG8_STAGE(bufoff, gbase, voff) do { _Pragma("unroll") for (int _i = 0; _i < 2; ++_i) \
        __builtin_amdgcn_global_load_lds((const unsigned*)((const char*)(gbase) + (voff)[_i]), (LAS unsigned*)(lds + (bufoff) + ldsw + _i * 8192), 16, 0, 0); } while (0)
#define PG8_LDA(dst, b, h) do { _Pragma("unroll") for (int m = 0; m < 4; ++m) _Pragma("unroll") for (int k = 0; k < 2; ++k) dst[m][k] = *(const LAS bf16x8*)(lds + PG8_SA(b, h) + aoff + m * 2048 + k * 1024); } while (0)
#define PG8_LDB(dst, b, h) do { _Pragma("unroll") for (int n = 0; n < 2; ++n) _Pragma("unroll") for (int k = 0; k < 2; ++k) dst[n][k] = *(const LAS bf16x8*)(lds + PG8_SB(b, h) + boff + n * 2048 + k * 1024); } while (0)
#define PG8_MMA(ai, bj, At, Bt) do { __builtin_amdgcn_s_setprio(1); _Pragma("unroll") for (int m = 0; m < 4; ++m) _Pragma("unroll") for (int n = 0; n < 2; ++n) _Pragma("unroll") for (int k = 0; k < 2; ++k) \
        acc[ai][bj][m][n] = __builtin_amdgcn_mfma_f32_16x16x32_bf16(Bt[n][k], At[m][k], acc[ai][bj][m][n], 0, 0, 0); __builtin_amdgcn_s_setprio(0); } while (0)
#define PG8_WAIT_V(n) asm volatile("s_waitcnt vmcnt(" #n ")" ::: "memory")
#define PG8_WAIT_L(n) asm volatile("s_waitcnt lgkmcnt(" #n ")" ::: "memory")
#define PG8_BAR __builtin_amdgcn_s_barrier()
#define PG8_SCHED __builtin_amdgcn_sched_barrier(0)
    Unit cur, nxt; int ui = 0;
    if (!S.next(0, cur)) return;
    f32x4 acc[2][2][4][2];
#pragma unroll
    for (int a = 0; a < 2; ++a)
#pragma unroll
        for (int b = 0; b < 2; ++b)
#pragma unroll
            for (int m = 0; m < 4; ++m)
#pragma unroll
                for (int n = 0; n < 2; ++n) acc[a][b][m][n] = (f32x4){0.f, 0.f, 0.f, 0.f};
    bf16x8 At[4][2], B0[2][2], B1[2][2];
    const char* cA = g.a_ptr(cur); const char* cB = g.b_ptr(cur);
    PG8_STAGE(PG8_SB(0, 0), cB, voffB); PG8_STAGE(PG8_SB(0, 1), cB + hstepB, voffB); PG8_STAGE(PG8_SA(0, 0), cA, voffA); PG8_STAGE(PG8_SA(0, 1), cA + hstepA, voffA);
    if (wr == 1) PG8_BAR;
    PG8_WAIT_V(2); PG8_BAR;
    PG8_STAGE(PG8_SB(1, 0), cB + kstep, voffB); PG8_STAGE(PG8_SA(1, 0), cA + kstep, voffA); PG8_STAGE(PG8_SB(1, 1), cB + hstepB + kstep, voffB);
    PG8_WAIT_V(6); PG8_BAR;
    for (;;) {
        const bool has_next = S.next(ui + 1, nxt);
        const char* nA = has_next ? g.a_ptr(nxt) : cA; const char* nB = has_next ? g.b_ptr(nxt) : cB;
        for (int t = 0; t < nt; t += 2) {
            const bool last = (t == nt - 2);
            const char* a1 = cA + (size_t)(t + 1) * kstep;
            const char* a2 = last ? nA : cA + (size_t)(t + 2) * kstep; const char* b2 = last ? nB : cB + (size_t)(t + 2) * kstep;
            const char* a3 = a2 + kstep; const char* b3 = b2 + kstep;
            PG8_LDB(B0, 0, 0); PG8_LDB(B1, 0, 1); PG8_SCHED; PG8_LDA(At, 0, 0); PG8_STAGE(PG8_SA(1, 1), a1 + hstepA, voffA);
            PG8_WAIT_V(8); PG8_WAIT_L(0); PG8_BAR; PG8_MMA(0, 0, At, B0); PG8_MMA(0, 1, At, B1); PG8_BAR; PG8_SCHED;
            PG8_LDA(At, 0, 1); PG8_STAGE(PG8_SB(0, 0), b2, voffB); PG8_STAGE(PG8_SB(0, 1), b2 + hstepB, voffB); PG8_STAGE(PG8_SA(0, 0), a2, voffA);
            PG8_WAIT_V(8); PG8_WAIT_L(0); PG8_BAR; PG8_MMA(1, 0, At, B0); PG8_MMA(1, 1, At, B1); PG8_BAR; PG8_SCHED;
            PG8_LDB(B0, 1, 0); PG8_LDB(B1, 1, 1); PG8_SCHED; PG8_LDA(At, 1, 0); PG8_STAGE(PG8_SA(0, 1), a2 + hstepA, voffA);
            PG8_WAIT_V(8); PG8_WAIT_L(0); PG8_BAR; PG8_MMA(0, 0, At, B0); PG8_MMA(0, 1, At, B1); PG8_BAR; PG8_SCHED;
            PG8_LDA(At, 1, 1); PG8_STAGE(PG8_SB(1, 0), b3, voffB); PG8_STAGE(PG8_SB(1, 1), b3 + hstepB, voffB); PG8_STAGE(PG8_SA(1, 0), a3, voffA);
            PG8_WAIT_V(8); PG8_WAIT_L(0); PG8_BAR; PG8_MMA(1, 0, At, B0); PG8_MMA(1, 1, At, B1); PG8_BAR; PG8_SCHED;
        }
        if constexpr (ALIGN_EPI) { if (wr == 0) PG8_BAR; }
        if constexpr (Epi::FUSED2) { if (has_next) { int fr_e = fr, fq_e = fq, tid_e = tid; asm volatile("" : "+v"(fr_e), "+v"(fq_e), "+v"(tid_e));
            E.first(acc, cur, wr, wc, fr_e, fq_e, lds + STAGE_BYTES, tid_e); } }
        else if constexpr (!Epi::AFTER_DRAIN) { E(acc, cur, wr, wc, fr, fq); }
        if (!has_next) break;
#pragma unroll
        for (int a = 0; a < 2; ++a)
#pragma unroll
            for (int b = 0; b < 2; ++b)
#pragma unroll
                for (int m = 0; m < 4; ++m)
#pragma unroll
                    for (int n = 0; n < 2; ++n) acc[a][b][m][n] = (f32x4){0.f, 0.f, 0.f, 0.f};
        cur = nxt; cA = nA; cB = nB; ++ui;
        if constexpr (ALIGN_EPI) { if (wr == 1) PG8_BAR; }
    }
    PG8_WAIT_V(0);
    if constexpr (!ALIGN_EPI) { if (wr == 0) PG8_BAR; }
    PG8_BAR;
    if constexpr (Epi::FUSED2) { int fr_e = fr, fq_e = fq, tid_e = tid; asm volatile("" : "+v"(fr_e), "+v"(fq_e), "+v"(tid_e));
        E.last(acc, cur, wr, wc, fr_e, fq_e, lds + STAGE_BYTES, tid_e, tid_e & 63, wid); }
    else if constexpr (Epi::AFTER_DRAIN) { E.fused(acc, cur, wr, wc, fr, fq, lds, wid, lane); }
#undef PG8_SA
#undef PG8_SB
#undef PG8_STAGE
#undef PG8_LDA
#undef PG8_LDB
#undef PG8_MMA
#undef PG8_WAIT_V
#undef PG8_WAIT_L
#undef PG8_BAR
#undef PG8_SCHED
}
}

#ifndef PHMASK
#define PHMASK 0xffffffffu
#endif
#define PH(k) (((PHMASK) >> (k)) & 1u)
struct Args {
    const float *x, *mem, *w_in, *conv_w, *a_log, *dt_bias, *gdn_norm_w, *pool_w, *pool_scale, *w_out, *ln1_g, *ln1_b,
                *xq_w, *xk_w, *xv_w, *xo_w, *ln2_g, *ln2_b, *w_up, *w_down, *ln3_g, *ln3_b;
    float* out; unsigned char* ws;
};

__device__ __forceinline__ void p0_transpose_item(const float* W, int ldw, int nsrc, int nblk, int K, bf16_t* WT, int ndst, LAS float* scr, int item, int lane, const float* rscale = nullptr) {
    const int kb = item / nblk, nb = item % nblk, k0 = 64 * kb, n0 = 32 * nb;
    const int kr = lane >> 3, nc = (lane & 7) * 4;
    f32x4 v[8];
#pragma unroll
    for (int i = 0; i < 8; ++i) v[i] = *(const f32x4*)(W + (size_t)(k0 + kr + 8 * i) * ldw + nsrc + n0 + nc);
#pragma unroll
    for (int i = 0; i < 8; ++i)
#pragma unroll
        for (int e = 0; e < 4; ++e) scr[(kr + 8 * i) * 33 + nc + e] = v[i][e];
    asm volatile("s_waitcnt lgkmcnt(0)" ::: "memory");
    const int c = lane & 7;
#pragma unroll
    for (int j = 0; j < 4; ++j) { const int n = (lane >> 3) + 8 * j; const LAS float* s = scr + (8 * c) * 33 + n;
        const float rs = rscale ? rscale[n0 + n] : 1.0f;
        u32x4 o; o.x = cvt_pk_bf16(s[0 * 33] * rs, s[1 * 33] * rs); o.y = cvt_pk_bf16(s[2 * 33] * rs, s[3 * 33] * rs); o.z = cvt_pk_bf16(s[4 * 33] * rs, s[5 * 33] * rs); o.w = cvt_pk_bf16(s[6 * 33] * rs, s[7 * 33] * rs);
        *(u32x4*)(WT + (size_t)(ndst + n0 + n) * K + k0 + 8 * c) = o; }
    asm volatile("s_waitcnt lgkmcnt(0)" ::: "memory");
}
__device__ __forceinline__ void cvt_flat(const float* src, bf16_t* dst, size_t n8, size_t gtid, size_t NT) {
    for (size_t i = gtid; i < n8; i += NT) { const f32x4 a = ((const f32x4*)src)[2 * i], b = ((const f32x4*)src)[2 * i + 1];
        u32x4 o; o.x = cvt_pk_bf16(a[0], a[1]); o.y = cvt_pk_bf16(a[2], a[3]); o.z = cvt_pk_bf16(b[0], b[1]); o.w = cvt_pk_bf16(b[2], b[3]); ((u32x4*)dst)[i] = o; }
}
__device__ __forceinline__ float wave_sum(float v) {
#pragma unroll
    for (int o = 1; o < 64; o <<= 1) v += __shfl_xor(v, o);
    return v;
}
template <bool FINAL>
__device__ __forceinline__ void ln_pass(bf16_t* S, float* dstf, const float* g, const float* b, int gw, int NGW, int lane) {
    for (int row = gw; row < M_TOK; row += NGW) {
        u32x4* sr = (u32x4*)(S + (size_t)row * DM) + lane;
        float v[4][8]; float s = 0.f;
#pragma unroll
        for (int j = 0; j < 4; ++j) { const u32x4 raw = sr[64 * j];
#pragma unroll
            for (int e = 0; e < 4; ++e) { v[j][2 * e] = __uint_as_float(raw[e] << 16); v[j][2 * e + 1] = __uint_as_float(raw[e] & 0xffff0000u); s += v[j][2 * e] + v[j][2 * e + 1]; } }
        const float mean = wave_sum(s) * (1.f / DM); float s2 = 0.f;
#pragma unroll
        for (int j = 0; j < 4; ++j)
#pragma unroll
            for (int e = 0; e < 8; ++e) { v[j][e] -= mean; s2 += v[j][e] * v[j][e]; }
        const float rstd = 1.0f / sqrtf(wave_sum(s2) * (1.f / DM) + LN_EPS);
#pragma unroll
        for (int j = 0; j < 4; ++j) { const int c = 8 * lane + 512 * j;
            const f32x4 g0 = *(const f32x4*)(g + c), g1 = *(const f32x4*)(g + c + 4), b0 = *(const f32x4*)(b + c), b1 = *(const f32x4*)(b + c + 4);
            float o[8];
#pragma unroll
            for (int e = 0; e < 4; ++e) { o[e] = v[j][e] * rstd * g0[e] + b0[e]; o[4 + e] = v[j][4 + e] * rstd * g1[e] + b1[e]; }
            if (FINAL) { float* d = dstf + (size_t)row * DM + c; *(f32x4*)d = (f32x4){o[0], o[1], o[2], o[3]}; *(f32x4*)(d + 4) = (f32x4){o[4], o[5], o[6], o[7]}; }
            else { u32x4 w; w.x = cvt_pk_bf16(o[0], o[1]); w.y = cvt_pk_bf16(o[2], o[3]); w.z = cvt_pk_bf16(o[4], o[5]); w.w = cvt_pk_bf16(o[6], o[7]); sr[64 * j] = w; } }
    }
}

constexpr int PL_KN = 0, PL_QS = 17408, PL_RHS = 34816, PL_LM = 68608, PL_AS = 84992, PL_KDT = 94208;
constexpr int KN_LD = 136, RHS_LD = 264, AS_LD = 72, KDT_LD = 72;
constexpr int PL_CW = 114688;
struct PrepRaw { u32x4 x[3][5]; float bb, aa; };
__device__ __forceinline__ void gdn_prep_load(const Args& a, int unit, int tid, PrepRaw& R) {
    const int lane = tid & 63, bh = unit >> 5, chunk = unit & 31, b = bh >> 3, h = bh & 7, cc = tid & 15, r0 = 2 * (tid >> 4);
    const bf16_t* QKV = (const bf16_t*)(a.ws + WS_QKV);
#pragma unroll
    for (int s = 0; s < 3; ++s)
#pragma unroll
        for (int d = 0; d < 5; ++d) { const int t = chunk * 64 + r0 + d - 3;
            R.x[s][d] = (u32x4){0u, 0u, 0u, 0u};
            if (t >= 0) R.x[s][d] = *(const u32x4*)(QKV + ((size_t)b * SEQ + t) * 3072 + s * 1024 + h * 128 + cc * 8); }
    const float* ba = (const float*)(a.ws + WS_BA) + ((size_t)b * SEQ + (size_t)chunk * 64 + lane) * 16;
    const float* ba1 = (const float*)((const unsigned char*)a.out + 112 * MiB) + ((size_t)b * SEQ + (size_t)chunk * 64 + lane) * 16;
    R.bb = ba[h] + ba1[h]; R.aa = ba[8 + h] + ba1[8 + h];
}
__device__ __forceinline__ void gdn_prep_unit(LAS unsigned char* lds, const Args& a, int unit, const PrepRaw& R, int next_unit, PrepRaw& NXT) {
    int tid = threadIdx.x; asm volatile("" : "+v"(tid));
    const int lane = tid & 63, wid = __builtin_amdgcn_readfirstlane(tid >> 6);
    const int bh = unit >> 5, chunk = unit & 31, b = bh >> 3, h = bh & 7;
    const size_t row0 = (size_t)b * SEQ + (size_t)chunk * 64;
    unsigned char* ws = a.ws;
    const bf16_t* QKV = (const bf16_t*)(ws + WS_QKV);
    LAS bf16_t* KN = (LAS bf16_t*)(lds + PL_KN); LAS bf16_t* QS = (LAS bf16_t*)(lds + PL_QS); LAS bf16_t* RHS = (LAS bf16_t*)(lds + PL_RHS);
    LAS float* LM = (LAS float*)(lds + PL_LM); LAS bf16_t* AS = (LAS bf16_t*)(lds + PL_AS); LAS bf16_t* KDT = (LAS bf16_t*)(lds + PL_KDT);
    float gcum, beta;
    {
        const float bb = R.bb, aa = R.aa;
        beta = __builtin_amdgcn_rcpf(1.0f + __expf(-bb));
        const float xx = aa + a.dt_bias[h];
        const float sp = fmaxf(xx, 0.f) + log1pf(__expf(-fabsf(xx)));
        gcum = -__expf(a.a_log[h]) * sp;
#pragma unroll
        for (int o = 1; o < 64; o <<= 1) { const float t = __shfl_up(gcum, o); if (lane >= o) gcum += t; }
    }
    const float glast = __shfl(gcum, 63);
    const int cc = tid & 15, rp = tid >> 4;
    const int r0 = 2 * rp;
    float qv[2][8], kv[2][8], vv[2][8];
#pragma unroll
    for (int s = 0; s < 3; ++s) {
        const int col = s * 1024 + h * 128 + cc * 8;
        float xin[5][8];
#pragma unroll
        for (int d = 0; d < 5; ++d) { const int t = chunk * 64 + r0 + d - 3;
            const u32x4 raw = R.x[s][d]; (void)t;
#pragma unroll
            for (int e = 0; e < 4; ++e) { xin[d][2 * e] = __uint_as_float(raw[e] << 16); xin[d][2 * e + 1] = __uint_as_float(raw[e] & 0xffff0000u); } }
        float cw[4][8];
#pragma unroll
        for (int j = 0; j < 4; ++j) { const LAS float* cwp = (const LAS float*)(lds + PL_CW) + (s * 4 + j) * 128 + cc * 8; const f32x4 w0 = *(const LAS f32x4*)cwp, w1 = *(const LAS f32x4*)(cwp + 4);
#pragma unroll
            for (int e = 0; e < 4; ++e) { cw[j][e] = w0[e]; cw[j][4 + e] = w1[e]; } }
#pragma unroll
        for (int r = 0; r < 2; ++r)
#pragma unroll
            for (int e = 0; e < 8; ++e) { float acc = 0.f;
#pragma unroll
                for (int j = 0; j < 4; ++j) acc += cw[j][e] * xin[r + j][e];
                const float y = silu_f(acc);
                if (s == 0) qv[r][e] = y; else if (s == 1) kv[r][e] = y; else vv[r][e] = y; }
    }
#pragma unroll
    for (int r = 0; r < 2; ++r) { float sq = 0.f, sk = 0.f;
#pragma unroll
        for (int e = 0; e < 8; ++e) { sq += qv[r][e] * qv[r][e]; sk += kv[r][e] * kv[r][e]; }
        sq = row16_sum(sq); sk = row16_sum(sk);
        const float rq = __builtin_amdgcn_rsqf(sq + NORM_EPS) * 0.08838834764831845f, rk = __builtin_amdgcn_rsqf(sk + NORM_EPS);
#pragma unroll
        for (int e = 0; e < 8; ++e) { qv[r][e] *= rq; kv[r][e] *= rk; } }
    {
        float gi[2], bi[2];
#pragma unroll
        for (int r = 0; r < 2; ++r) { gi[r] = __shfl(gcum, r0 + r); bi[r] = __shfl(beta, r0 + r); }
        bf16_t* QGo = (bf16_t*)(ws + WS_QG) + (size_t)unit * 8192;
#pragma unroll
        for (int r = 0; r < 2; ++r) { const int i = r0 + r; const float eg = __expf(gi[r]), ed = __expf(glast - gi[r]);
            u32x4 w;
            w.x = cvt_pk_bf16(kv[r][0], kv[r][1]); w.y = cvt_pk_bf16(kv[r][2], kv[r][3]); w.z = cvt_pk_bf16(kv[r][4], kv[r][5]); w.w = cvt_pk_bf16(kv[r][6], kv[r][7]);
            *(LAS u32x4*)(KN + i * KN_LD + cc * 8) = w;
            w.x = cvt_pk_bf16(qv[r][0], qv[r][1]); w.y = cvt_pk_bf16(qv[r][2], qv[r][3]); w.z = cvt_pk_bf16(qv[r][4], qv[r][5]); w.w = cvt_pk_bf16(qv[r][6], qv[r][7]);
            *(LAS u32x4*)(QS + i * KN_LD + cc * 8) = w;
            const float bv_ = bi[r];
            w.x = cvt_pk_bf16(vv[r][0] * bv_, vv[r][1] * bv_); w.y = cvt_pk_bf16(vv[r][2] * bv_, vv[r][3] * bv_); w.z = cvt_pk_bf16(vv[r][4] * bv_, vv[r][5] * bv_); w.w = cvt_pk_bf16(vv[r][6] * bv_, vv[r][7] * bv_);
            *(LAS u32x4*)(RHS + i * RHS_LD + cc * 8) = w;
            const float bk = bi[r] * eg;
            w.x = cvt_pk_bf16(kv[r][0] * bk, kv[r][1] * bk); w.y = cvt_pk_bf16(kv[r][2] * bk, kv[r][3] * bk); w.z = cvt_pk_bf16(kv[r][4] * bk, kv[r][5] * bk); w.w = cvt_pk_bf16(kv[r][6] * bk, kv[r][7] * bk);
            *(LAS u32x4*)(RHS + i * RHS_LD + 128 + cc * 8) = w;
            w.x = cvt_pk_bf16(qv[r][0] * eg, qv[r][1] * eg); w.y = cvt_pk_bf16(qv[r][2] * eg, qv[r][3] * eg); w.z = cvt_pk_bf16(qv[r][4] * eg, qv[r][5] * eg); w.w = cvt_pk_bf16(qv[r][6] * eg, qv[r][7] * eg);
            *(u32x4*)(QGo + (size_t)i * 128 + cc * 8) = w;
#pragma unroll
            for (int e = 0; e < 8; ++e) kv[r][e] *= ed;
        }
#pragma unroll
        for (int e = 0; e < 8; ++e) *(LAS unsigned*)(KDT + (cc * 8 + e) * KDT_LD + r0) = cvt_pk_bf16(kv[0][e], kv[1][e]);
        if (tid == 0) ((float*)(ws + WS_GL))[(size_t)unit * 32] = __expf(glast);
    }
    LDS_BARRIER();
    {
        const int which = wid >> 2, mi = wid & 3, fr = lane & 15, fq = lane >> 4;
        LAS bf16_t* Asrc = which ? QS : KN;
        bf16x8 af[4];
#pragma unroll
        for (int kk = 0; kk < 4; ++kk) af[kk] = *(const LAS bf16x8*)(Asrc + (mi * 16 + fr) * KN_LD + kk * 32 + fq * 8);
        float gi4[4], bi4[4];
#pragma unroll
        for (int jj = 0; jj < 4; ++jj) { gi4[jj] = __shfl(gcum, mi * 16 + fq * 4 + jj); bi4[jj] = __shfl(beta, mi * 16 + fq * 4 + jj); }
#pragma unroll
        for (int ni = 0; ni < 4; ++ni) {
            const float gj = __shfl(gcum, ni * 16 + fr);
            f32x4 acc = (f32x4){0.f, 0.f, 0.f, 0.f};
            if (ni <= mi) {
#pragma unroll
                for (int kk = 0; kk < 4; ++kk) { const bf16x8 bfrag = *(const LAS bf16x8*)(KN + (ni * 16 + fr) * KN_LD + kk * 32 + fq * 8);
                    acc = __builtin_amdgcn_mfma_f32_16x16x32_bf16(af[kk], bfrag, acc, 0, 0, 0); }
            }
            const int j = ni * 16 + fr;
#pragma unroll
            for (int jj = 0; jj < 4; ++jj) { const int i = mi * 16 + fq * 4 + jj;
                const float dec = (i >= j) ? __expf(gi4[jj] - gj) : 0.f;
                if (which == 0) LM[i * 64 + j] = (i > j) ? bi4[jj] * acc[jj] * dec : 0.f;
                else AS[i * AS_LD + j] = (bf16_t)(cvt_pk_bf16(acc[jj] * dec, 0.f) & 0xffffu); }
        }
    }
    LDS_BARRIER();
    gdn_prep_load(a, next_unit, tid, NXT);
    if (wid < 4) {
        const int c = tid;
        int vz; asm volatile("v_mov_b32 %0, 0" : "=v"(vz));
        const LAS float* LMv = LM + vz;
        f32x2 X2[32];
#pragma unroll
        for (int i = 0; i < 64; ++i) {
            float r = bf2f((unsigned)RHS[i * RHS_LD + c]);
            f32x2 pa = (f32x2){0.f, 0.f}, pb = (f32x2){0.f, 0.f};
#pragma unroll
            for (int j4 = 0; j4 < (i + 3) / 4; ++j4) { const f32x4 l = *(const LAS f32x4*)(LMv + i * 64 + j4 * 4);
                if (j4 * 4 + 1 < i) pa = (f32x2){l[0], l[1]} * X2[j4 * 2] + pa;
                else if (j4 * 4 < i) pa.x += l[0] * X2[j4 * 2].x;
                if (j4 * 4 + 3 < i) pb = (f32x2){l[2], l[3]} * X2[j4 * 2 + 1] + pb;
                else if (j4 * 4 + 2 < i) pb.x += l[2] * X2[j4 * 2 + 1].x; }
            r -= (pa.x + pa.y) + (pb.x + pb.y);
            if (i & 1) X2[i >> 1].y = r; else X2[i >> 1].x = r;
            if (c >= 128) RHS[i * RHS_LD + c] = (bf16_t)(cvt_pk_bf16(r, 0.f) & 0xffffu);
        }
        if (c < 128) {
            bf16_t* UTo = (bf16_t*)(ws + WS_UT) + (size_t)unit * 8192 + (size_t)c * 64;
#pragma unroll
            for (int q8 = 0; q8 < 8; ++q8) { u32x4 w; w.x = cvt_pk_bf16(X2[q8 * 4 + 0].x, X2[q8 * 4 + 0].y); w.y = cvt_pk_bf16(X2[q8 * 4 + 1].x, X2[q8 * 4 + 1].y); w.z = cvt_pk_bf16(X2[q8 * 4 + 2].x, X2[q8 * 4 + 2].y); w.w = cvt_pk_bf16(X2[q8 * 4 + 3].x, X2[q8 * 4 + 3].y);
                *(u32x4*)(UTo + q8 * 8) = w; }
        }
    } else {
        const int t2 = tid - 256;
        bf16_t* AIo = (bf16_t*)(ws + WS_AI) + (size_t)unit * 4096; bf16_t* KDo = (bf16_t*)(ws + WS_KDT) + (size_t)unit * 8192;
#pragma unroll
        for (int p = 0; p < 2; ++p) { const int piece = t2 + 256 * p, r = piece >> 3, cseg = piece & 7;
            *(u32x4*)(AIo + r * 64 + cseg * 8) = *(const LAS u32x4*)(AS + r * AS_LD + cseg * 8); }
#pragma unroll
        for (int p = 0; p < 4; ++p) { const int piece = t2 + 256 * p, r = piece >> 3, cseg = piece & 7;
            *(u32x4*)(KDo + r * 64 + cseg * 8) = *(const LAS u32x4*)(KDT + r * KDT_LD + cseg * 8); }
    }
    LDS_BARRIER();
    {
        bf16_t* Wo = (bf16_t*)(ws + WS_W) + (size_t)unit * 8192;
#pragma unroll
        for (int p = 0; p < 2; ++p) { const int piece = tid + 512 * p, r = piece >> 4, cseg = piece & 15;
            *(u32x4*)(Wo + r * 128 + cseg * 8) = *(const LAS u32x4*)(RHS + r * RHS_LD + 128 + cseg * 8); }
    }
    LDS_BARRIER();
}

constexpr int SL_SBT = 0, SL_VNT = 34816, SL_RED = 34816 + 18432;
constexpr int SBT_LD = 136, VNT_LD = 72;
constexpr int SL_OST = 53760, OST_LD = 68;
__device__ __forceinline__ void gdn_scan(LAS unsigned char* lds, const Args& a, int bh) {
    int tid = threadIdx.x; asm volatile("" : "+v"(tid));
    const int lane = tid & 63, wid = __builtin_amdgcn_readfirstlane(tid >> 6), fr = lane & 15, fq = lane >> 4;
    const int it = wid & 3, vh = wid >> 2, kt0 = 2 * (wid & 3);
    const int b = bh >> 3, h = bh & 7;
    unsigned char* ws = a.ws;
    LAS bf16_t* SBT = (LAS bf16_t*)(lds + SL_SBT); LAS bf16_t* VNT = (LAS bf16_t*)(lds + SL_VNT); LAS float* RED = (LAS float*)(lds + SL_RED);
    const bf16_t* Wg = (const bf16_t*)(ws + WS_W); const bf16_t* QG = (const bf16_t*)(ws + WS_QG); const bf16_t* AI = (const bf16_t*)(ws + WS_AI);
    const bf16_t* KD = (const bf16_t*)(ws + WS_KDT); const bf16_t* UT = (const bf16_t*)(ws + WS_UT); const float* GL = (const float*)(ws + WS_GL);
    const bf16_t* Z = (const bf16_t*)(ws + WS_Z); bf16_t* MIX = (bf16_t*)((unsigned char*)a.out + 32 * MiB);
    for (int i = tid; i < (34816 + 18432) / 4; i += 512) ((LAS unsigned*)lds)[i] = 0u;
    f32x4 S[2][4];
#pragma unroll
    for (int t = 0; t < 2; ++t)
#pragma unroll
        for (int vt = 0; vt < 4; ++vt) S[t][vt] = (f32x4){0.f, 0.f, 0.f, 0.f};
    LAS float* OST = (LAS float*)(lds + SL_OST + wid * (16 * OST_LD * 4));
    const int orow_l = lane >> 2, oseg = lane & 3;
    f32x4 nw4[4];
#pragma unroll
    for (int q = 0; q < 4; ++q) nw4[q] = *(const f32x4*)(a.gdn_norm_w + vh * 64 + oseg * 16 + q * 4);
    LDS_BARRIER();
    bf16x8 wA[4], qA[4], aA[2], kA[2][2]; u32x2 uu[4]; u32x4 z0, z1; float egl;
#define SCAN_LOAD1(U) do { _Pragma("unroll") for (int kk = 0; kk < 4; ++kk) { wA[kk] = *(const bf16x8*)(Wg + (U) * 8192 + (it * 16 + fr) * 128 + kk * 32 + fq * 8); qA[kk] = *(const bf16x8*)(QG + (U) * 8192 + (it * 16 + fr) * 128 + kk * 32 + fq * 8); } \
        _Pragma("unroll") for (int vt = 0; vt < 4; ++vt) uu[vt] = *(const u32x2*)(UT + (U) * 8192 + (size_t)(vh * 64 + vt * 16 + fr) * 64 + it * 16 + fq * 4); } while (0)
#define SCAN_LOAD2(U) do { _Pragma("unroll") for (int k2 = 0; k2 < 2; ++k2) { aA[k2] = *(const bf16x8*)(AI + (U) * 4096 + (it * 16 + fr) * 64 + k2 * 32 + fq * 8); \
            _Pragma("unroll") for (int t = 0; t < 2; ++t) kA[t][k2] = *(const bf16x8*)(KD + (U) * 8192 + ((kt0 + t) * 16 + fr) * 64 + k2 * 32 + fq * 8); } \
        egl = GL[(U) * 32]; } while (0)
#define SCAN_LOADZ(N) do { const size_t zr_ = (size_t)b * SEQ + (size_t)(N) * 64 + it * 16 + orow_l; z0 = *(const u32x4*)(Z + zr_ * 1024 + h * 128 + vh * 64 + oseg * 16); z1 = *(const u32x4*)(Z + zr_ * 1024 + h * 128 + vh * 64 + oseg * 16 + 8); } while (0)
    { const size_t u0_ = (size_t)bh * 32; SCAN_LOAD1(u0_); SCAN_LOAD2(u0_); SCAN_LOADZ(0); }
#pragma unroll 2
    for (int n = 0; n < NCHUNK; ++n) {
        if (n == LATE0 - 2) {
            if (tid == 0) { unsigned sp = 0u; while (__hip_atomic_load((unsigned*)(ws + WS_FLAGS) + 64 * bh, __ATOMIC_RELAXED, __HIP_MEMORY_SCOPE_AGENT) == 0u) { __builtin_amdgcn_s_sleep(4); if (++sp > (1u << 22)) break; }
                __builtin_amdgcn_fence(__ATOMIC_ACQUIRE, "agent"); asm volatile("s_waitcnt vmcnt(0)" ::: "memory"); }
            LDS_BARRIER();
        }
        const size_t unit = (size_t)bh * 32 + n;
        const size_t un = (n + 1 < NCHUNK) ? unit + 1 : unit;
        const int nn = (n + 1 < NCHUNK) ? n + 1 : n;
        const size_t orow = (size_t)b * SEQ + (size_t)n * 64 + it * 16 + orow_l;
        asm volatile("" : "+v"(uu[0]), "+v"(uu[1]), "+v"(uu[2]), "+v"(uu[3]));
        f32x4 accO[4];
        {
            bf16x8 bfr[4][4];
#pragma unroll
            for (int vt = 0; vt < 4; ++vt)
#pragma unroll
                for (int kk = 0; kk < 4; ++kk) bfr[vt][kk] = *(const LAS bf16x8*)(SBT + (vh * 64 + vt * 16 + fr) * SBT_LD + kk * 32 + fq * 8);
#pragma unroll
            for (int vt = 0; vt < 4; ++vt) {
                f32x4 accF = (f32x4){0.f, 0.f, 0.f, 0.f}; accO[vt] = (f32x4){0.f, 0.f, 0.f, 0.f};
#pragma unroll
                for (int kk = 0; kk < 4; ++kk) {
                    accF = __builtin_amdgcn_mfma_f32_16x16x32_bf16(wA[kk], bfr[vt][kk], accF, 0, 0, 0);
                    accO[vt] = __builtin_amdgcn_mfma_f32_16x16x32_bf16(qA[kk], bfr[vt][kk], accO[vt], 0, 0, 0); }
                const float u0 = __uint_as_float(uu[vt].x << 16), u1 = __uint_as_float(uu[vt].x & 0xffff0000u), u2 = __uint_as_float(uu[vt].y << 16), u3 = __uint_as_float(uu[vt].y & 0xffff0000u);
                u32x2 w; w.x = cvt_pk_bf16(u0 - accF[0], u1 - accF[1]); w.y = cvt_pk_bf16(u2 - accF[2], u3 - accF[3]);
                *(LAS u32x2*)(VNT + (vh * 64 + vt * 16 + fr) * VNT_LD + it * 16 + fq * 4) = w;
            }
        }
        asm volatile("" ::: "memory");
        SCAN_LOAD1(un);
        LDS_BARRIER();
        asm volatile("" : "+v"(egl));
        {
            bf16x8 vb[4][2];
#pragma unroll
            for (int vt = 0; vt < 4; ++vt)
#pragma unroll
                for (int k2 = 0; k2 < 2; ++k2) vb[vt][k2] = *(const LAS bf16x8*)(VNT + (vh * 64 + vt * 16 + fr) * VNT_LD + k2 * 32 + fq * 8);
#pragma unroll
            for (int vt = 0; vt < 4; ++vt) {
#pragma unroll
                for (int k2 = 0; k2 < 2; ++k2) accO[vt] = __builtin_amdgcn_mfma_f32_16x16x32_bf16(aA[k2], vb[vt][k2], accO[vt], 0, 0, 0);
#pragma unroll
                for (int t = 0; t < 2; ++t) { f32x4 sv = S[t][vt] * egl;
#pragma unroll
                    for (int k2 = 0; k2 < 2; ++k2) sv = __builtin_amdgcn_mfma_f32_16x16x32_bf16(kA[t][k2], vb[vt][k2], sv, 0, 0, 0);
                    S[t][vt] = sv;
                    u32x2 w; w.x = cvt_pk_bf16(sv[0], sv[1]); w.y = cvt_pk_bf16(sv[2], sv[3]);
                    *(LAS u32x2*)(SBT + (vh * 64 + vt * 16 + fr) * SBT_LD + (kt0 + t) * 16 + fq * 4) = w; }
            }
        }
        {
            float ss[4];
#pragma unroll
            for (int jj = 0; jj < 4; ++jj) { float s = 0.f;
#pragma unroll
                for (int vt = 0; vt < 4; ++vt) s += accO[vt][jj] * accO[vt][jj];
                s = row16_sum(s);
                ss[jj] = s; }
            if (fr == 0) {
#pragma unroll
                for (int jj = 0; jj < 4; ++jj) RED[(it * 16 + fq * 4 + jj) * 2 + vh] = ss[jj]; }
        }
        asm volatile("" ::: "memory");
        SCAN_LOAD2(un);
        LDS_BARRIER();
        asm volatile("" : "+v"(z0), "+v"(z1));
#pragma unroll
        for (int jj = 0; jj < 4; ++jj) { const f32x2 rr = *(const LAS f32x2*)(RED + (it * 16 + fq * 4 + jj) * 2);
            const float rstd = __builtin_amdgcn_rsqf((rr.x + rr.y) * (1.0f / 128.0f) + NORM_EPS);
#pragma unroll
            for (int vt = 0; vt < 4; ++vt) OST[(fq * 4 + jj) * OST_LD + vt * 16 + fr] = accO[vt][jj] * rstd; }
        asm volatile("s_waitcnt lgkmcnt(0)" ::: "memory");
        {
            f32x4 ov[4];
#pragma unroll
            for (int q = 0; q < 4; ++q) ov[q] = *(const LAS f32x4*)(OST + orow_l * OST_LD + oseg * 16 + q * 4) * nw4[q];
            float zf[16];
#pragma unroll
            for (int e = 0; e < 4; ++e) { zf[2 * e] = __uint_as_float(z0[e] << 16); zf[2 * e + 1] = __uint_as_float(z0[e] & 0xffff0000u); zf[8 + 2 * e] = __uint_as_float(z1[e] << 16); zf[8 + 2 * e + 1] = __uint_as_float(z1[e] & 0xffff0000u); }
            float of[16];
#pragma unroll
            for (int q = 0; q < 4; ++q)
#pragma unroll
                for (int e = 0; e < 4; ++e) of[q * 4 + e] = ov[q][e] * silu_f(zf[q * 4 + e]);
            u32x4 w0, w1;
            w0.x = cvt_pk_bf16(of[0], of[1]); w0.y = cvt_pk_bf16(of[2], of[3]); w0.z = cvt_pk_bf16(of[4], of[5]); w0.w = cvt_pk_bf16(of[6], of[7]);
            w1.x = cvt_pk_bf16(of[8], of[9]); w1.y = cvt_pk_bf16(of[10], of[11]); w1.z = cvt_pk_bf16(of[12], of[13]); w1.w = cvt_pk_bf16(of[14], of[15]);
            bf16_t* mp = MIX + orow * 2048 + h * 128 + vh * 64 + oseg * 16;
            *(u32x4*)mp = w0; *(u32x4*)(mp + 8) = w1;
        }
        asm volatile("s_waitcnt lgkmcnt(0)" ::: "memory");
        SCAN_LOADZ(nn);
    }
    LDS_BARRIER();
}


#define XB_TMO      128
#define XB_XCNT(j)  (256  + 64 * (j))
#define XB_XSUB(j)  (1280 + 64 * (j))
#define XB_XGEN(j)  (2304 + 64 * (j))
#define XB_TOP      3328
#define XB_TOPGEN   3392
#define XCD_BAR_WORDS 3456
#define XB_SPIN_CAP (1u << 20)
__device__ __forceinline__ unsigned xb_ld(unsigned* p)              { return __hip_atomic_load(p, __ATOMIC_RELAXED, __HIP_MEMORY_SCOPE_AGENT); }
__device__ __forceinline__ unsigned xb_add(unsigned* p, unsigned v) { return __hip_atomic_fetch_add(p, v, __ATOMIC_RELAXED, __HIP_MEMORY_SCOPE_AGENT); }
__device__ __forceinline__ unsigned xb_xcc_id() { return (unsigned)__builtin_amdgcn_s_getreg((3 << 11) | 20) & 0xFu; }
#define XB_SPIN(cond, bar) do { unsigned _sp = 0; while (cond) { __builtin_amdgcn_s_sleep(1); \
    if ((++_sp & 255u) == 0u) { if (xb_ld(&(bar)[XB_TMO])) break; if (_sp > XB_SPIN_CAP) { atomicAdd(&(bar)[XB_TMO], 1u); break; } } } } while (0)
struct XcdBarrier { unsigned* bar; unsigned x; volatile LAS unsigned* st; };
__device__ __forceinline__ XcdBarrier xcd_barrier_post(unsigned* bar, volatile LAS unsigned* st) {
    XcdBarrier b; b.bar = bar; b.x = xb_xcc_id(); b.st = st;
    if (threadIdx.x == 0) (void)xb_add(&bar[XB_XCNT(b.x)], 1u);
    return b;
}
__device__ __forceinline__ void xcd_barrier_complete(unsigned* bar, unsigned x, unsigned& nloc, unsigned& nx) {
    const unsigned G = gridDim.x * gridDim.y * gridDim.z;
    unsigned sum, cnt, mine, sp = 0u;
    for (;;) {
        sum = 0u; cnt = 0u; mine = 0u;
#pragma unroll
        for (unsigned j = 0; j < 16; ++j) { const unsigned c = xb_ld(&bar[XB_XCNT(j)]); sum += c; cnt += (c > 0u) ? 1u : 0u; mine = (j == x) ? c : mine; }
        if (sum == G) break;
        __builtin_amdgcn_s_sleep(1);
        if ((++sp & 255u) == 0u) { if (xb_ld(&bar[XB_TMO])) break; if (sp > XB_SPIN_CAP) { atomicAdd(&bar[XB_TMO], 1u); break; } }
    }
    nloc = mine > 0u ? mine : 1u; nx = cnt > 0u ? cnt : 1u;
}
__device__ __forceinline__ void xcd_barrier(const XcdBarrier& b) {
    asm volatile("s_waitcnt vmcnt(0)" ::: "memory");
    __syncthreads();
    if (threadIdx.x == 0) {
        unsigned* bar = b.bar;
        __builtin_amdgcn_s_waitcnt(0);
        unsigned nloc = b.st[0], nx = b.st[1];
        if (nloc == 0u) { xcd_barrier_complete(bar, b.x, nloc, nx); b.st[0] = nloc; b.st[1] = nx; }
        const unsigned old = xb_add(&bar[XB_XSUB(b.x)], 1u);
        const unsigned gen = old / nloc;
        if (old + 1u == (gen + 1u) * nloc) {
            __builtin_amdgcn_fence(__ATOMIC_RELEASE, "agent");
            asm volatile("s_waitcnt vmcnt(0)" ::: "memory");
            const unsigned og = xb_add(&bar[XB_TOP], 1u);
            const unsigned tg = og / nx;
            if (og + 1u == (tg + 1u) * nx) xb_add(&bar[XB_TOPGEN], 1u);
            else XB_SPIN(xb_ld(&bar[XB_TOPGEN]) == tg, bar);
            __builtin_amdgcn_fence(__ATOMIC_ACQUIRE, "agent");
            xb_add(&bar[XB_XGEN(b.x)], 1u);
            asm volatile("s_waitcnt vmcnt(0)" ::: "memory");
        } else {
            XB_SPIN(xb_ld(&bar[XB_XGEN(b.x)]) == gen, bar);
            __builtin_amdgcn_fence(__ATOMIC_ACQUIRE, "agent");
            asm volatile("s_waitcnt vmcnt(0)" ::: "memory");
        }
    }
    __syncthreads();
}

__global__ void __launch_bounds__(512, 2) hybrid_fwd(Args a) {
    extern __shared__ __attribute__((aligned(16))) unsigned char lds_raw[];
    LAS unsigned char* lds = (LAS unsigned char*)lds_raw;
    const int tid = threadIdx.x, lane = tid & 63, wave = __builtin_amdgcn_readfirstlane(tid >> 6);
    const int G = gridDim.x, bid = blockIdx.x;
    const int gw = bid * 8 + wave, NGW = G * 8;
    const size_t gtid = (size_t)bid * 512 + tid, NT = (size_t)G * 512;
    unsigned char* ws = a.ws;
    volatile LAS unsigned* MISC = (volatile LAS unsigned*)(lds + 143 * 1024);
    if (tid < 2) MISC[tid] = 0u;
    __syncthreads();
    const XcdBarrier gbar = xcd_barrier_post((unsigned*)(ws + WS_CTL), MISC);
#define GRID_SYNC() xcd_barrier(gbar)
#define WUP ((bf16_t*)(ws + WS_WUP))
#define WDN ((bf16_t*)(ws + WS_WDN))
#define WIN ((bf16_t*)(ws + WS_WIN))
#define WOUT ((bf16_t*)(ws + WS_WOUT))
#define WQ ((bf16_t*)(ws + WS_WQ))
#define WK ((bf16_t*)(ws + WS_WK))
#define WV ((bf16_t*)(ws + WS_WV))
#define WO ((bf16_t*)(ws + WS_WO))
#define WPOOL ((bf16_t*)(ws + WS_WPOOL))
#define WBA ((bf16_t*)(ws + WS_WBA))
#define XB ((bf16_t*)(ws + WS_XB))
#define MEMB ((bf16_t*)(ws + WS_MEMB))
#define HB ((bf16_t*)(ws + WS_HB))
#define STATS ((float*)(ws + WS_STATS))

    {
        LAS float* scr = (LAS float*)(lds + wave * 16384);
        constexpr int I_IN0 = 32 * 128, I_IN1 = 32 * 32, I_PL = 4 * 8;
        constexpr int NITEMS = I_IN0 + I_IN1 + 4 * I_PL;
        for (int it = gw; it < NITEMS; it += NGW) {
            int r = it;
            if (r < I_IN0) { p0_transpose_item(a.w_in, W_INLD, 0, 128, 2048, WIN, 0, scr, r, lane); continue; } r -= I_IN0;
            if (r < I_IN1) { p0_transpose_item(a.w_in, W_INLD, 4112, 32, 2048, WIN, 4096, scr, r, lane); continue; } r -= I_IN1;
            const int gpool = r / I_PL; r -= gpool * I_PL;
            p0_transpose_item(a.pool_w + (size_t)gpool * 65536, 256, 0, 8, 256, WPOOL + (size_t)gpool * 65536, 0, scr, r, lane, a.pool_scale + gpool * 256);
        }
        for (size_t e = gtid; e < 16 * 2048; e += NT) { const int n = (int)(e >> 11), k = (int)(e & 2047); WBA[e] = (bf16_t)(cvt_pk_bf16(a.w_in[(size_t)k * W_INLD + 4096 + n], 0.f) & 0xffffu); }
        cvt_flat(a.x, XB, (size_t)M_TOK * DM / 8, gtid, NT);
    }
    GRID_SYNC();

    {
        {
            const int unit = (wave & 3) * G + bid, khalf = wave >> 2;
            if (unit < M_TOK / 16) {
                const int fr = lane & 15, fq = lane >> 4;
                f32x4 acc = (f32x4){0.f, 0.f, 0.f, 0.f};
                const bf16_t* ap = XB + (size_t)(unit * 16 + fr) * DM + khalf * 1024 + fq * 8; const bf16_t* bp = WBA + (size_t)fr * DM + khalf * 1024 + fq * 8;
#pragma unroll 16
                for (int kk = 0; kk < 32; ++kk) { const bf16x8 af = *(const bf16x8*)(ap + kk * 32), bf = *(const bf16x8*)(bp + kk * 32);
                    acc = __builtin_amdgcn_mfma_f32_16x16x32_bf16(af, bf, acc, 0, 0, 0); }
                float* ba = khalf ? (float*)((unsigned char*)a.out + 112 * MiB) : (float*)(ws + WS_BA);
#pragma unroll
                for (int j = 0; j < 4; ++j) ba[(size_t)(unit * 16 + fq * 4 + j) * 16 + fr] = acc[j];
            }
        }
        __syncthreads();
        pg8::Gemm g{XB, WIN, DM, DM, DM, 0, 0, 0, 0}; pg8::Order S; S.init(M_TOK / 256, 5120 / 256, 1, 1, G, bid);
        typedef pg8::EpiBf16<0, pg8::MapG1> E1; E1 E{pg8::MapG1{(bf16_t*)(ws + WS_QKV), (bf16_t*)(ws + WS_Z), (bf16_t*)(ws + WS_P)}, 1.f};
        if (PH(1)) pg8::gemm_phase<E1, true>(lds, g, S, E);
    }
    GRID_SYNC();

    {
#ifndef NO_PREP
        {
            {
                LAS float* scr = (LAS float*)(lds + wave * 16384);
                constexpr int I_SQ = 32 * 64;
                for (int it = gw; it < 2 * I_SQ; it += NGW) {
                    if (it < I_SQ) p0_transpose_item(a.xk_w, 2048, 0, 64, 2048, WK, 0, scr, it, lane);
                    else p0_transpose_item(a.xv_w, 2048, 0, 64, 2048, WV, 0, scr, it - I_SQ, lane); }
                cvt_flat(a.mem, MEMB, (size_t)2048 * DM / 8, gtid, NT);
                __syncthreads();
            }
            if (tid < 384) { const int sq = tid >> 7, ch = tid & 127, h0 = (bid >> 5) & 7;
#pragma unroll
                for (int j = 0; j < 4; ++j) ((LAS float*)(lds + PL_CW))[(sq * 4 + j) * 128 + ch] = a.conv_w[(size_t)j * 3072 + sq * 1024 + h0 * 128 + ch]; }
            __syncthreads();
            const int h0_ = (bid >> 5) & 7, j0_ = bid & 31;
#define EARLY_UNIT(T) ((((T) / LATE0) * 8 + h0_) * 32 + ((T) % LATE0))
            PrepRaw cur, nxt;
            gdn_prep_load(a, EARLY_UNIT(j0_), tid, cur);
            for (int t = j0_; t < 8 * LATE0; t += 32) {
                const int tn = (t + 32 < 8 * LATE0) ? t + 32 : t;
                gdn_prep_unit(lds, a, EARLY_UNIT(t), cur, EARLY_UNIT(tn), nxt);
                cur = nxt;
            }
#undef EARLY_UNIT
        }
#endif
        const bf16_t* PP = (const bf16_t*)(ws + WS_P); bf16_t* PO = (bf16_t*)a.out;
        for (size_t idx = gtid; idx < (size_t)M_TOK * 128; idx += NT) {
            const size_t row = idx >> 7; const int ch = (int)(idx & 127), gi = ch >> 5, win = 2 << gi, t = (int)(row & 2047);
            const int n = (t + 1 < win) ? t + 1 : win;
            float s[8], c0[8];
#pragma unroll
            for (int e = 0; e < 8; ++e) s[e] = 0.f;
            u32x4 raw[16];
#pragma unroll
            for (int k = 0; k < 16; ++k) { raw[k] = (u32x4){0u, 0u, 0u, 0u}; if (k < n) raw[k] = *(const u32x4*)(PP + (row - k) * 1024 + ch * 8); }
#pragma unroll
            for (int k = 0; k < 16; ++k)
#pragma unroll
                for (int e = 0; e < 4; ++e) { const float lo = __uint_as_float(raw[k][e] << 16), hi = __uint_as_float(raw[k][e] & 0xffff0000u); s[2 * e] += lo; s[2 * e + 1] += hi; if (k == 0) { c0[2 * e] = lo; c0[2 * e + 1] = hi; } }
            const float inv = 1.0f / (float)n;
            u32x4 w; w.x = cvt_pk_bf16(s[0] * inv - c0[0], s[1] * inv - c0[1]); w.y = cvt_pk_bf16(s[2] * inv - c0[2], s[3] * inv - c0[3]);
            w.z = cvt_pk_bf16(s[4] * inv - c0[4], s[5] * inv - c0[5]); w.w = cvt_pk_bf16(s[6] * inv - c0[6], s[7] * inv - c0[7]);
            *(u32x4*)(PO + row * 1024 + ch * 8) = w;
        }
    }
    GRID_SYNC();

    {
#ifndef NO_SCAN
        if (bid < 64) gdn_scan(lds, a, bid);
        else
#endif
        if (bid < 128) {
            pg8::Gemm g{MEMB, WK, DM, DM, DM, 0, 0, 0, 0}; pg8::Order S; S.init(8, 8, 1, 1, 64, bid - 64);
            typedef pg8::EpiBf16<0, pg8::MapPlain> E1; E1 E{pg8::MapPlain{(bf16_t*)((unsigned char*)a.out + 96 * MiB), 2048}, 1.f};
            if (PH(2)) pg8::gemm_phase<E1, true>(lds, g, S, E);
        } else if (bid < 192) {
            pg8::Gemm g{MEMB, WV, DM, DM, DM, 0, 0, 0, 0}; pg8::Order S; S.init(8, 8, 1, 1, 64, bid - 128);
            typedef pg8::EpiBf16<0, pg8::MapPlain> E1; E1 E{pg8::MapPlain{(bf16_t*)((unsigned char*)a.out + 104 * MiB), 2048}, 1.f};
            if (PH(3)) pg8::gemm_phase<E1, true>(lds, g, S, E);
        } else {
#ifndef NO_PREP
            {
                const int bhl = bid - 192;
                __syncthreads();
                if (tid < 384) { const int sq = tid >> 7, ch = tid & 127, hl = bhl & 7;
#pragma unroll
                    for (int j = 0; j < 4; ++j) ((LAS float*)(lds + PL_CW))[(sq * 4 + j) * 128 + ch] = a.conv_w[(size_t)j * 3072 + sq * 1024 + hl * 128 + ch]; }
                __syncthreads();
                PrepRaw cur, nxt;
                gdn_prep_load(a, bhl * 32 + LATE0, tid, cur);
                for (int c = LATE0; c < NCHUNK; ++c) { const int cn = (c + 1 < NCHUNK) ? c + 1 : c;
                    gdn_prep_unit(lds, a, bhl * 32 + c, cur, bhl * 32 + cn, nxt); cur = nxt; }
                asm volatile("s_waitcnt vmcnt(0)" ::: "memory"); __syncthreads();
                if (tid == 0) { __builtin_amdgcn_fence(__ATOMIC_RELEASE, "agent"); asm volatile("s_waitcnt vmcnt(0)" ::: "memory");
                    __hip_atomic_store((unsigned*)(ws + WS_FLAGS) + 64 * bhl, 1u, __ATOMIC_RELAXED, __HIP_MEMORY_SCOPE_AGENT); }
                __syncthreads();
            }
#endif
            pg8::Gemm g{(const bf16_t*)a.out, WPOOL, 1024, 256, 256, 0, 256, 0, 65536}; pg8::Order S; S.init(64, 1, 1, 4, G - 192, bid - 192);
            typedef pg8::EpiBf16<0, pg8::MapPool> E1; E1 E{pg8::MapPool{(bf16_t*)((unsigned char*)a.out + 32 * MiB)}, 1.f};
            if (PH(4)) pg8::gemm_phase<E1, true>(lds, g, S, E);
        }
        if (bid >= 64) {
            LAS float* scr = (LAS float*)(lds + wave * 16384);
            constexpr int I_SQ = 32 * 64, I_UP = 32 * 256, I_DN = 128 * 64, NIT = 2 * I_SQ + I_UP + I_DN;
            constexpr int NIT_A = NIT * 8 / 9;
            const bool kvb = bid < 192;
            for (int it = kvb ? (bid - 64) * 8 + wave : NIT_A + (bid - 192) * 8 + wave; it < (kvb ? NIT_A : NIT); it += (kvb ? 128 : 64) * 8) {
                int r = it;
                if (r < I_SQ) { p0_transpose_item(a.w_out, 2048, 0, 64, 2048, WOUT, 0, scr, r, lane); continue; } r -= I_SQ;
                if (r < I_SQ) { p0_transpose_item(a.xo_w, 2048, 0, 64, 2048, WO, 0, scr, r, lane); continue; } r -= I_SQ;
                if (r < I_UP) { p0_transpose_item(a.w_up, 8192, 0, 256, 2048, WUP, 0, scr, r, lane); continue; } r -= I_UP;
                p0_transpose_item(a.w_down, 2048, 0, 64, 8192, WDN, 0, scr, r, lane);
            }
            cvt_flat(a.xq_w, WQ, (size_t)DM * DM / 8, gtid - (size_t)64 * 512, (size_t)(G - 64) * 512);
        }
    }
    GRID_SYNC();

    {
        pg8::Gemm g{(const bf16_t*)((unsigned char*)a.out + 32 * MiB), WOUT, DM, DM, DM, (long)2048 * 2048, 0, 0, 0}; pg8::PanelOrder S; S.init(G, bid);
        typedef pg8::EpiLn2<false, false> E1; E1 E{HB, nullptr, nullptr, a.ln1_g, a.ln1_b, (unsigned long long*)(ws + WS_XCH), (unsigned*)(ws + WS_CTL + 16384)};
        if (PH(5)) pg8::gemm_phase<E1, true, pg8::PanelOrder>(lds, g, S, E);
    }
    {
        pg8::GemmAB g{pg8::Gemm{(const bf16_t*)((unsigned char*)a.out + 96 * MiB), WQ, DM, DM, 512, (long)256 * 2048, 512, 0, 512}, pg8::Gemm{WO, (const bf16_t*)((unsigned char*)a.out + 104 * MiB), DM, DM, 512, 0, 512, (long)256 * 2048, 512}, DM, DM, 512}; pg8::ABOrder S{bid};
        typedef pg8::EpiBf16<0, pg8::MapAB> E1; E1 E{pg8::MapAB{(bf16_t*)(ws + WS_G), (bf16_t*)(ws + WS_VOT)}, 1.f};
        if (G == 256 && PH(6)) pg8::gemm_phase<E1, true, pg8::ABOrder, pg8::GemmAB>(lds, g, S, E);
    }
    GRID_SYNC();

    {
        pg8::Gemm g{HB, (const bf16_t*)(ws + WS_G), DM, DM, DM, (long)2048 * 2048, 0, (long)4 * 256 * 2048, (long)256 * 2048}; pg8::Order S; S.init(8, 1, 8, 4, G, bid);
        pg8::EpiSoftmax E{(bf16_t*)(ws + WS_PR), 0.044194173824159216f * 1.4426950408889634f};
        if (G == 256 && PH(7)) pg8::gemm_phase<pg8::EpiSoftmax, false>(lds, g, S, E);
    }
    GRID_SYNC();
    {
        pg8::Gemm g{(const bf16_t*)(ws + WS_PR), (const bf16_t*)(ws + WS_VOT), 1024, 1024, 1024, (long)2048 * 1024, 0, (long)2048 * 1024, 0}; pg8::PanelOrder S; S.init(G, bid);
        typedef pg8::EpiLn2<false, false> E1; E1 E{HB, nullptr, nullptr, a.ln2_g, a.ln2_b, (unsigned long long*)(ws + WS_XCH) + (size_t)64 * 256 * 4, (unsigned*)(ws + WS_CTL + 2 * 16384)};
        if (PH(9)) pg8::gemm_phase<E1, true, pg8::PanelOrder>(lds, g, S, E);
    }
    GRID_SYNC();
    {
        pg8::Gemm g{HB, WUP, DM, DM, DM, 0, 0, 0, 0}; pg8::Order S; S.init(64, 32, 1, 1, G, bid);
        typedef pg8::EpiBf16<2, pg8::MapPlain> E1; E1 E{pg8::MapPlain{(bf16_t*)(ws + WS_HID), DFF}, 1.f};
        if (PH(10)) pg8::gemm_phase<E1, true>(lds, g, S, E);
    }
    GRID_SYNC();
    {
        pg8::Gemm g{(const bf16_t*)(ws + WS_HID), WDN, DFF, DFF, DFF, (long)2048 * DFF, 0, 0, 0}; pg8::PanelOrder S; S.init(G, bid);
        typedef pg8::EpiLn2<false, true> E1; E1 E{HB, nullptr, a.out, a.ln3_g, a.ln3_b, (unsigned long long*)(ws + WS_XCH) + (size_t)2 * 64 * 256 * 4, (unsigned*)(ws + WS_CTL + 3 * 16384)};
        if (PH(11)) pg8::gemm_phase<E1, true, pg8::PanelOrder>(lds, g, S, E);
    }
}

extern "C" void kernel_launch(void* const* d_in, const int* in_sizes, int n_in, void* d_out, int out_size, void* d_ws, size_t ws_size, hipStream_t stream) {
    static int grid = 0;
    if (grid == 0) {
        if (n_in != 22 || out_size != M_TOK * DM || ws_size < WS_END) { fprintf(stderr, "kernel_launch: unexpected problem (n_in %d out %d ws %zu)\n", n_in, out_size, ws_size); grid = -1; return; }
        int dev = 0, cus = 0, per_cu = 0;
        hipGetDevice(&dev); hipDeviceGetAttribute(&cus, hipDeviceAttributeMultiprocessorCount, dev);
        hipFuncSetAttribute((const void*)hybrid_fwd, hipFuncAttributeMaxDynamicSharedMemorySize, LDS_BYTES);
        hipOccupancyMaxActiveBlocksPerMultiprocessor(&per_cu, (const void*)hybrid_fwd, 512, LDS_BYTES);
        if (per_cu < 1) { fprintf(stderr, "kernel_launch: occupancy query says %d blocks per CU\n", per_cu); per_cu = 1; }
        grid = cus;
        if (grid > cus * per_cu) grid = cus * per_cu;
        (void)hipGetLastError();
    }
    if (grid < 0) return;
    if (hipMemsetAsync((char*)d_ws + WS_CTL, 0, CTL_BYTES, stream) != hipSuccess) { fprintf(stderr, "kernel_launch: memset failed\n"); return; }
    Args a{};
    const float** pa = (const float**)&a;
    for (int i = 0; i < 22; ++i) pa[i] = (const float*)d_in[i];
    a.out = (float*)d_out; a.ws = (unsigned char*)d_ws;
    void* args[] = {&a};
    hipError_t e = hipLaunchCooperativeKernel((const void*)hybrid_fwd, dim3(grid), dim3(512), args, LDS_BYTES, stream);
    if (e != hipSuccess) fprintf(stderr, "cooperative launch failed: %s (grid %d)\n", hipGetErrorString(e), grid);
}
```

```cpp
#include <hip/hip_runtime.h>
#include <hip/hip_cooperative_groups.h>
#include <cstdio>
#include <cstdint>
namespace cg = cooperative_groups;

#define LAS __attribute__((address_space(3)))
typedef unsigned short bf16_t;
typedef short bf16x8 __attribute__((ext_vector_type(8)));
typedef float f32x4 __attribute__((ext_vector_type(4)));
typedef float f32x2 __attribute__((ext_vector_type(2)));
typedef unsigned u32x4 __attribute__((ext_vector_type(4)));
typedef unsigned u32x2 __attribute__((ext_vector_type(2)));

constexpr int M_TOK = 16384, DM = 2048, SEQ = 2048, NBATCH = 8, DFF = 8192;
constexpr int W_INLD = 5136;
constexpr int NCHUNK = 32;
constexpr float ALPHA = 1.189207115002721f;
constexpr float LN_EPS = 1e-5f, NORM_EPS = 1e-6f;
constexpr size_t MiB = 1024ull * 1024ull;
constexpr size_t WS_WUP = 0, WS_WDN = 32 * MiB, WS_WIN = 64 * MiB, WS_WOUT = 84 * MiB, WS_WQ = 92 * MiB, WS_WK = 100 * MiB,
                 WS_WV = 108 * MiB, WS_WO = 116 * MiB, WS_WPOOL = 124 * MiB, WS_WBA = 124 * MiB + 512 * 1024, WS_BA = 125 * MiB,
                 WS_STATS = 126 * MiB, WS_GL = 126 * MiB + 512 * 1024;
constexpr size_t WS_MEMB = 128 * MiB, WS_XB = 136 * MiB, WS_POOLED = 136 * MiB, WS_HB = 136 * MiB;
constexpr size_t WS_QKV = 200 * MiB, WS_Z = 296 * MiB, WS_P = 328 * MiB;
constexpr size_t WS_W = 360 * MiB, WS_QG = 392 * MiB, WS_KDT = 424 * MiB, WS_AI = 456 * MiB, WS_UT = 472 * MiB;
constexpr size_t WS_MIX = 200 * MiB, WS_KX = 264 * MiB, WS_VX = 272 * MiB;
constexpr size_t WS_G = 296 * MiB, WS_VOT = 328 * MiB;
constexpr size_t WS_Q = 296 * MiB, WS_PR = 200 * MiB, WS_O = 296 * MiB, WS_HID = 200 * MiB;
constexpr size_t WS_XCH = 504 * MiB;
constexpr size_t WS_END = 506 * MiB;
constexpr size_t WS_CTL = 127 * MiB; constexpr size_t CTL_BYTES = 81920;
constexpr size_t WS_FLAGS = WS_CTL + 65536;
constexpr int LATE0 = 28;
constexpr int LDS_BYTES = 144 * 1024;

#define LDS_BARRIER() do { asm volatile("s_waitcnt lgkmcnt(0)" ::: "memory"); __builtin_amdgcn_s_barrier(); asm volatile("" ::: "memory"); } while (0)
__device__ __forceinline__ float bf2f(unsigned h) { return __uint_as_float(h << 16); }
typedef __bf16 bf16x2_t __attribute__((ext_vector_type(2)));
__device__ __forceinline__ unsigned cvt_pk_bf16(float lo, float hi) { const f32x2 v = {lo, hi}; const bf16x2_t r = __builtin_convertvector(v, bf16x2_t); return __builtin_bit_cast(unsigned, r); }
template <int CTRL> __device__ __forceinline__ float dpp_mov(float v) { return __builtin_bit_cast(float, __builtin_amdgcn_update_dpp(0, __builtin_bit_cast(int, v), CTRL, 0xf, 0xf, true)); }
__device__ __forceinline__ float row16_sum(float v) { v += dpp_mov<0xB1>(v); v += dpp_mov<0x4E>(v); v += dpp_mov<0x141>(v); v += dpp_mov<0x140>(v); return v; }
__device__ __forceinline__ float silu_f(float x) { return x * __builtin_amdgcn_rcpf(1.0f + __expf(-x)); }

namespace pg8 {
constexpr int BM = 256, BK = 64, HALF = 128, HTB = HALF * BK * 2, STAGE_BYTES = 8 * HTB, NXCD = 8, WGM = 4;
__device__ __forceinline__ int lds_byte(int r, int c) { const int st = (r >> 4) * 2 + (c >> 5), rr = r & 15, cc = c & 31, ob = rr * 64 + cc * 2; return st * 1024 + (ob ^ (((ob >> 9) & 1) << 5)); }
__device__ __forceinline__ void stage_rc(int b, int& R, int& C) { const int st = b / 1024, sb = b % 1024, swz = sb ^ (((sb >> 9) & 1) << 5); R = (st >> 1) * 16 + swz / 64; C = (st & 1) * 32 + (swz % 64) / 2; }
__device__ __forceinline__ int perm32(int rho) { const int n = rho >> 4, i = rho & 15; return 8 * (i >> 2) + 4 * n + (i & 3); }

struct Unit { int pm, pn, z0, z1; };
struct Gemm {
    const bf16_t* A; const bf16_t* Bt; int lda, ldb, K; long a_z0, a_z1, b_z0, b_z1;
    __device__ __forceinline__ const char* a_ptr(const Unit& u) const { return (const char*)(A + u.z0 * a_z0 + u.z1 * a_z1 + (long)u.pm * BM * lda); }
    __device__ __forceinline__ const char* b_ptr(const Unit& u) const { return (const char*)(Bt + u.z0 * b_z0 + u.z1 * b_z1 + (long)u.pn * BM * ldb); }
};
struct Order {
    int nM, nN, nZ1, per, total, G, c;
    __device__ __forceinline__ void init(int nM_, int nN_, int nZ0_, int nZ1_, int G_, int c_) { nM = nM_; nN = nN_; nZ1 = nZ1_; per = nM * nN; total = per * nZ0_ * nZ1_; G = G_; c = c_; }
    __device__ __forceinline__ bool next(int i, Unit& u) const {
        const long L = (long)i * G + c; if (c < 0 || L >= total) return false;
        if (total == per) {
            int wgid = (int)L; { const int nwg = per, q = nwg / NXCD, r = nwg % NXCD, xcd = wgid % NXCD, off = wgid / NXCD; wgid = (xcd < r ? xcd * (q + 1) : r * (q + 1) + (xcd - r) * q) + off; }
            const int nig = WGM * nN, gid = wgid / nig, fm = gid * WGM, gsz = (nM - fm) < WGM ? (nM - fm) : WGM;
            u.pm = fm + ((wgid % nig) % gsz); u.pn = (wgid % nig) / gsz; u.z0 = 0; u.z1 = 0;
        } else {
            const int zb = (int)(L / per), w = (int)(L % per);
            u.pm = w % nM; u.pn = w / nM; u.z0 = zb / nZ1; u.z1 = zb % nZ1;
        }
        return true;
    }
};

struct MapPlain { bf16_t* O; int ldc;
    __device__ __forceinline__ void get(const Unit& u, bf16_t*& p, int& ld) const { p = O + (size_t)u.pm * BM * ldc + u.pn * BM; ld = ldc; } };
struct MapG1 { bf16_t *qkv, *z, *pp;
    __device__ __forceinline__ void get(const Unit& u, bf16_t*& p, int& ld) const {
        const int colt = u.pn * BM; const size_t row0 = (size_t)u.pm * BM;
        if (colt < 3072) { p = qkv + row0 * 3072 + colt; ld = 3072; } else if (colt < 4096) { p = z + row0 * 1024 + (colt - 3072); ld = 1024; } else { p = pp + row0 * 1024 + (colt - 4096); ld = 1024; } } };
struct MapPool { bf16_t* mix;
    __device__ __forceinline__ void get(const Unit& u, bf16_t*& p, int& ld) const { p = mix + (size_t)u.pm * BM * 2048 + 1024 + u.z1 * 256; ld = 2048; } };
struct MapG { bf16_t* g;
    __device__ __forceinline__ void get(const Unit& u, bf16_t*& p, int& ld) const { p = g + ((size_t)(u.z0 * 4 + u.z1) * 256) * 2048 + u.pn * BM; ld = 2048; } };
struct MapVOT { bf16_t* v;
    __device__ __forceinline__ void get(const Unit& u, bf16_t*& p, int& ld) const { p = v + ((size_t)u.z0 * 2048 + (size_t)u.pm * BM) * 1024 + u.z1 * 256; ld = 1024; } };
struct MapO { bf16_t* o;
    __device__ __forceinline__ void get(const Unit& u, bf16_t*& p, int& ld) const { p = o + ((size_t)u.z0 * 2048 + (size_t)u.pm * BM) * 2048 + u.z1 * 512 + u.pn * BM; ld = 2048; } };

template <int ACT  , class Map, bool SCALED = false> struct EpiBf16 {
    static constexpr bool PERM = true, AFTER_DRAIN = false, FUSED2 = false;
    Map map; float scale;
    __device__ __forceinline__ void operator()(const f32x4 (&acc)[2][2][4][2], const Unit& u, int wr, int wc, int fr, int fq) const {
        bf16_t* base; int ldc; map.get(u, base, ldc);
        const int row0 = wr * 64 + fr, col0 = wc * 32 + 8 * fq;
#pragma unroll
        for (int ai = 0; ai < 2; ++ai)
#pragma unroll
            for (int m = 0; m < 4; ++m) { bf16_t* rowp = base + (size_t)(row0 + ai * HALF + m * 16) * ldc + col0;
#pragma unroll
                for (int bj = 0; bj < 2; ++bj) { f32x4 v0 = acc[ai][bj][m][0], v1 = acc[ai][bj][m][1];
                    if (ACT == 2) {
#pragma unroll
                        for (int j = 0; j < 4; ++j) { const float a = fmaxf(v0[j], 0.f), b = fmaxf(v1[j], 0.f); v0[j] = a * a; v1[j] = b * b; } }
                    if (SCALED) { v0 = v0 * scale; v1 = v1 * scale; }
                    u32x4 w; w.x = cvt_pk_bf16(v0[0], v0[1]); w.y = cvt_pk_bf16(v0[2], v0[3]); w.z = cvt_pk_bf16(v1[0], v1[1]); w.w = cvt_pk_bf16(v1[2], v1[3]);
                    *(u32x4*)(rowp + bj * HALF) = w; } }
    }
};
template <bool LN> struct EpiResid {
    static constexpr bool PERM = false, AFTER_DRAIN = false, FUSED2 = false;
    float* out; const float* base; const float* stats; const float* g; const float* b;
    __device__ __forceinline__ void operator()(const f32x4 (&acc)[2][2][4][2], const Unit& u, int wr, int wc, int fr, int fq) const {
        const int col0 = u.pn * BM + wc * 32 + 4 * fq;
#pragma unroll
        for (int ai = 0; ai < 2; ++ai)
#pragma unroll
            for (int m = 0; m < 4; ++m) { const int r = u.pm * BM + ai * HALF + wr * 64 + m * 16 + fr; const size_t off = (size_t)r * DM + col0;
                f32x2 st = (f32x2){0.f, 1.f}; if (LN) st = *(const f32x2*)(stats + 2 * (size_t)r);
#pragma unroll
                for (int bj = 0; bj < 2; ++bj)
#pragma unroll
                    for (int n = 0; n < 2; ++n) { f32x4 rs = *(const f32x4*)((LN ? (const float*)out : base) + off + bj * HALF + n * 16);
                        if (LN) { const f32x4 gv = *(const f32x4*)(g + col0 + bj * HALF + n * 16), bv = *(const f32x4*)(b + col0 + bj * HALF + n * 16); rs = (rs - st.x) * st.y * gv + bv; }
                        *(f32x4*)(out + off + bj * HALF + n * 16) = rs * ALPHA + acc[ai][bj][m][n]; }
                asm volatile("" ::: "memory");
            }
    }
};
template <bool FROMX> struct EpiStream {
    static constexpr bool PERM = true, AFTER_DRAIN = false, FUSED2 = false;
    bf16_t* S; const float* x;
    __device__ __forceinline__ void operator()(const f32x4 (&acc)[2][2][4][2], const Unit& u, int wr, int wc, int fr, int fq) const {
        const int col0 = u.pn * BM + wc * 32 + 8 * fq;
#pragma unroll
        for (int ai = 0; ai < 2; ++ai)
#pragma unroll
            for (int m = 0; m < 4; ++m) { const size_t off = (size_t)(u.z0 * 2048 + u.pm * BM + ai * HALF + wr * 64 + m * 16 + fr) * DM + col0;
#pragma unroll
                for (int bj = 0; bj < 2; ++bj) { f32x4 r0, r1;
                    if (FROMX) { r0 = *(const f32x4*)(x + off + bj * HALF); r1 = *(const f32x4*)(x + off + bj * HALF + 4); }
                    else { const u32x4 raw = *(const u32x4*)(S + off + bj * HALF);
                        r0 = (f32x4){__uint_as_float(raw.x << 16), __uint_as_float(raw.x & 0xffff0000u), __uint_as_float(raw.y << 16), __uint_as_float(raw.y & 0xffff0000u)};
                        r1 = (f32x4){__uint_as_float(raw.z << 16), __uint_as_float(raw.z & 0xffff0000u), __uint_as_float(raw.w << 16), __uint_as_float(raw.w & 0xffff0000u)}; }
                    const f32x4 v0 = r0 * ALPHA + acc[ai][bj][m][0], v1 = r1 * ALPHA + acc[ai][bj][m][1];
                    u32x4 w; w.x = cvt_pk_bf16(v0[0], v0[1]); w.y = cvt_pk_bf16(v0[2], v0[3]); w.z = cvt_pk_bf16(v1[0], v1[1]); w.w = cvt_pk_bf16(v1[2], v1[3]);
                    *(u32x4*)(S + off + bj * HALF) = w; }
                asm volatile("" ::: "memory"); }
    }
};
struct EpiSoftmax {
    static constexpr bool PERM = true, AFTER_DRAIN = true, FUSED2 = false;
    bf16_t* P; float scale_log2;
    __device__ __forceinline__ void fused(f32x4 (&acc)[2][2][4][2], const Unit& u, int wr, int wc, int fr, int fq, LAS unsigned char* lds, int wid, int lane) const {
        LAS f32x2* X = (LAS f32x2*)lds;
        float mxs[2][4];
#pragma unroll
        for (int ai = 0; ai < 2; ++ai)
#pragma unroll
            for (int m = 0; m < 4; ++m) {
                float mx = -3.0e38f;
#pragma unroll
                for (int bj = 0; bj < 2; ++bj)
#pragma unroll
                    for (int n = 0; n < 2; ++n) { f32x4 v = acc[ai][bj][m][n] * scale_log2; acc[ai][bj][m][n] = v; mx = fmaxf(mx, fmaxf(fmaxf(v[0], v[1]), fmaxf(v[2], v[3]))); }
                mx = fmaxf(mx, __shfl_xor(mx, 16)); mx = fmaxf(mx, __shfl_xor(mx, 32));
                float s = 0.f;
#pragma unroll
                for (int bj = 0; bj < 2; ++bj)
#pragma unroll
                    for (int n = 0; n < 2; ++n) { f32x4 v = acc[ai][bj][m][n];
#pragma unroll
                        for (int j = 0; j < 4; ++j) { v[j] = __builtin_amdgcn_exp2f(v[j] - mx); s += v[j]; }
                        acc[ai][bj][m][n] = v; }
                s += __shfl_xor(s, 16); s += __shfl_xor(s, 32);
                mxs[ai][m] = mx;
                if (fq == 0) X[(ai * HALF + wr * 64 + m * 16 + fr) * 4 + wc] = (f32x2){mx, s};
            }
        asm volatile("s_waitcnt lgkmcnt(0)" ::: "memory"); __builtin_amdgcn_s_barrier(); asm volatile("" ::: "memory");
        const size_t rowg = (size_t)u.z0 * 2048 + (size_t)u.pm * BM;
#pragma unroll
        for (int ai = 0; ai < 2; ++ai)
#pragma unroll
            for (int m = 0; m < 4; ++m) { const int r = ai * HALF + wr * 64 + m * 16 + fr;
                const f32x2 a = X[r * 4 + 0], b = X[r * 4 + 1], c = X[r * 4 + 2], d = X[r * 4 + 3];
                const float mt = fmaxf(fmaxf(a.x, b.x), fmaxf(c.x, d.x));
                const float S = a.y * __builtin_amdgcn_exp2f(a.x - mt) + b.y * __builtin_amdgcn_exp2f(b.x - mt) + c.y * __builtin_amdgcn_exp2f(c.x - mt) + d.y * __builtin_amdgcn_exp2f(d.x - mt);
                const float f = __builtin_amdgcn_exp2f(mxs[ai][m] - mt) / S;
                bf16_t* rowp = P + (rowg + r) * 1024 + u.z1 * 256 + wc * 32 + 8 * fq;
#pragma unroll
                for (int bj = 0; bj < 2; ++bj) { const f32x4 v0 = acc[ai][bj][m][0] * f, v1 = acc[ai][bj][m][1] * f;
                    u32x4 w; w.x = cvt_pk_bf16(v0[0], v0[1]); w.y = cvt_pk_bf16(v0[2], v0[3]); w.z = cvt_pk_bf16(v1[0], v1[1]); w.w = cvt_pk_bf16(v1[2], v1[3]);
                    *(u32x4*)(rowp + bj * HALF) = w; } }
    }
};

struct PanelOrder {
    int gp, q; bool ok;
    __device__ __forceinline__ void init(int G, int bid) { ok = (G == 256); const int vc = (bid & 7) * 32 + (bid >> 3); gp = vc >> 2; q = vc & 3; }
    __device__ __forceinline__ bool next(int i, Unit& u) const { if (!ok || i > 1) return false; u.z0 = gp >> 3; u.pm = gp & 7; u.pn = 2 * q + i; u.z1 = 0; return true; }
};
template <bool FROMX, bool FINAL> struct EpiLn2 {
    static constexpr bool PERM = true, AFTER_DRAIN = false, FUSED2 = true;
    bf16_t* S; const float* x; float* outf; const float* g; const float* b; unsigned long long* slots; unsigned* cnt;
    __device__ __forceinline__ void values_stats(f32x4 (&acc)[2][2][4][2], const Unit& u, int wr, int wc, int fr, int fq, LAS f32x2* P1) const {
        const int col0 = u.pn * BM + wc * 32 + 8 * fq;
#pragma unroll
        for (int ai = 0; ai < 2; ++ai)
#pragma unroll
            for (int m = 0; m < 4; ++m) { const int rl = ai * HALF + wr * 64 + m * 16 + fr; const size_t off = (size_t)(u.z0 * 2048 + u.pm * BM + rl) * DM + col0;
                float s1 = 0.f, s2 = 0.f;
#pragma unroll
                for (int bj = 0; bj < 2; ++bj) { f32x4 r0, r1;
                    if (FROMX) { r0 = *(const f32x4*)(x + off + bj * HALF); r1 = *(const f32x4*)(x + off + bj * HALF + 4); }
                    else { const u32x4 raw = *(const u32x4*)(S + off + bj * HALF);
                        r0 = (f32x4){__uint_as_float(raw.x << 16), __uint_as_float(raw.x & 0xffff0000u), __uint_as_float(raw.y << 16), __uint_as_float(raw.y & 0xffff0000u)};
                        r1 = (f32x4){__uint_as_float(raw.z << 16), __uint_as_float(raw.z & 0xffff0000u), __uint_as_float(raw.w << 16), __uint_as_float(raw.w & 0xffff0000u)}; }
                    const f32x4 v0 = r0 * ALPHA + acc[ai][bj][m][0], v1 = r1 * ALPHA + acc[ai][bj][m][1];
                    acc[ai][bj][m][0] = v0; acc[ai][bj][m][1] = v1;
                    s1 += ((v0[0] + v0[1]) + (v0[2] + v0[3])) + ((v1[0] + v1[1]) + (v1[2] + v1[3]));
                    s2 += ((v0[0] * v0[0] + v0[1] * v0[1]) + (v0[2] * v0[2] + v0[3] * v0[3])) + ((v1[0] * v1[0] + v1[1] * v1[1]) + (v1[2] * v1[2] + v1[3] * v1[3]));
                    asm volatile("" ::: "memory"); }
                s1 += __shfl_xor(s1, 16); s1 += __shfl_xor(s1, 32); s2 += __shfl_xor(s2, 16); s2 += __shfl_xor(s2, 32);
                if (fq == 0) P1[rl * 4 + wc] = (f32x2){s1, s2};
                asm volatile("" ::: "memory"); }
    }
    __device__ __forceinline__ void first(f32x4 (&acc)[2][2][4][2], const Unit& u, int wr, int wc, int fr, int fq, LAS unsigned char* ldsx, int tid) const {
        LAS f32x2* P1 = (LAS f32x2*)ldsx; LAS f32x2* T0 = (LAS f32x2*)(ldsx + 8192);
        values_stats(acc, u, wr, wc, fr, fq, P1);
        const int col0 = u.pn * BM + wc * 32 + 8 * fq;
#pragma unroll
        for (int ai = 0; ai < 2; ++ai)
#pragma unroll
            for (int m = 0; m < 4; ++m) { const size_t off = (size_t)(u.z0 * 2048 + u.pm * BM + ai * HALF + wr * 64 + m * 16 + fr) * DM + col0;
#pragma unroll
                for (int bj = 0; bj < 2; ++bj) { const f32x4 v0 = acc[ai][bj][m][0], v1 = acc[ai][bj][m][1];
                    u32x4 w; w.x = cvt_pk_bf16(v0[0], v0[1]); w.y = cvt_pk_bf16(v0[2], v0[3]); w.z = cvt_pk_bf16(v1[0], v1[1]); w.w = cvt_pk_bf16(v1[2], v1[3]);
                    *(u32x4*)(S + off + bj * HALF) = w; } }
        LDS_BARRIER();
        if (tid < 256) { const f32x2 a = P1[tid * 4 + 0], b2 = P1[tid * 4 + 1], c = P1[tid * 4 + 2], d = P1[tid * 4 + 3]; T0[tid] = (f32x2){(a.x + b2.x) + (c.x + d.x), (a.y + b2.y) + (c.y + d.y)}; }
        LDS_BARRIER();
    }
    __device__ __forceinline__ void last(f32x4 (&acc)[2][2][4][2], const Unit& u, int wr, int wc, int fr, int fq, LAS unsigned char* ldsx, int tid, int lane, int wid) const {
        LAS f32x2* P1 = (LAS f32x2*)ldsx; LAS f32x2* T0 = (LAS f32x2*)(ldsx + 8192); LAS f32x2* ST = (LAS f32x2*)(ldsx + 10240);
        values_stats(acc, u, wr, wc, fr, fq, P1);
        LDS_BARRIER();
        const int gp = u.z0 * 8 + u.pm, q = u.pn >> 1;
        unsigned long long* slot = slots + ((size_t)gp * 256 + (tid & 255)) * 4;
        if (tid < 256) { const f32x2 a = P1[tid * 4 + 0], b2 = P1[tid * 4 + 1], c = P1[tid * 4 + 2], d = P1[tid * 4 + 3], t0 = T0[tid];
            const float s1 = t0.x + ((a.x + b2.x) + (c.x + d.x)), s2 = t0.y + ((a.y + b2.y) + (c.y + d.y));
            __hip_atomic_store(slot + q, ((unsigned long long)__float_as_uint(s2) << 32) | __float_as_uint(s1), __ATOMIC_RELAXED, __HIP_MEMORY_SCOPE_AGENT); }
        asm volatile("s_waitcnt vmcnt(0)" ::: "memory");
        if (wid < 4 && lane == 0) __hip_atomic_fetch_add(cnt + 64 * gp, 1u, __ATOMIC_RELAXED, __HIP_MEMORY_SCOPE_AGENT);
        if (wid == 0) { unsigned sp = 0u;
            while ((unsigned)__builtin_amdgcn_readfirstlane(__hip_atomic_load(cnt + 64 * gp, __ATOMIC_RELAXED, __HIP_MEMORY_SCOPE_AGENT)) < 16u) { __builtin_amdgcn_s_sleep(2); if (++sp > (1u << 22)) break; }
            __builtin_amdgcn_fence(__ATOMIC_ACQUIRE, "agent"); }
        asm volatile("s_waitcnt vmcnt(0) lgkmcnt(0)" ::: "memory"); __builtin_amdgcn_s_barrier(); asm volatile("" ::: "memory");
        if (tid < 256) { float s1 = 0.f, s2 = 0.f;
#pragma unroll
            for (int t = 0; t < 4; ++t) { const unsigned long long w = __hip_atomic_load(slot + t, __ATOMIC_RELAXED, __HIP_MEMORY_SCOPE_AGENT); s1 += __uint_as_float((unsigned)w); s2 += __uint_as_float((unsigned)(w >> 32)); }
            const float mean = s1 * (1.0f / DM); const float var = fmaxf(s2 * (1.0f / DM) - mean * mean, 0.f);
            ST[tid] = (f32x2){mean, 1.0f / sqrtf(var + LN_EPS)}; }
        LDS_BARRIER();
#pragma unroll
        for (int pass = 0; pass < 2; ++pass) {
            const int col0 = (u.pn - pass) * BM + wc * 32 + 8 * fq;
#pragma unroll
            for (int ai = 0; ai < 2; ++ai)
#pragma unroll
                for (int m = 0; m < 4; ++m) { const int rl = ai * HALF + wr * 64 + m * 16 + fr; const size_t off = (size_t)(u.z0 * 2048 + u.pm * BM + rl) * DM + col0; const f32x2 st = ST[rl];
#pragma unroll
                    for (int bj = 0; bj < 2; ++bj) { f32x4 v0, v1;
                        if (pass == 0) { v0 = acc[ai][bj][m][0]; v1 = acc[ai][bj][m][1]; }
                        else { const u32x4 raw = *(const u32x4*)(S + off + bj * HALF);
                            v0 = (f32x4){__uint_as_float(raw.x << 16), __uint_as_float(raw.x & 0xffff0000u), __uint_as_float(raw.y << 16), __uint_as_float(raw.y & 0xffff0000u)};
                            v1 = (f32x4){__uint_as_float(raw.z << 16), __uint_as_float(raw.z & 0xffff0000u), __uint_as_float(raw.w << 16), __uint_as_float(raw.w & 0xffff0000u)}; }
                        f32x4 o0, o1;
                        { const f32x4 g0 = *(const f32x4*)(g + col0 + bj * HALF), b0 = *(const f32x4*)(b + col0 + bj * HALF); o0 = (v0 - st.x) * st.y * g0 + b0; }
                        if (FINAL) { *(f32x4*)(outf + off + bj * HALF) = o0; asm volatile("" ::: "memory"); }
                        { const f32x4 g1 = *(const f32x4*)(g + col0 + bj * HALF + 4), b1 = *(const f32x4*)(b + col0 + bj * HALF + 4); o1 = (v1 - st.x) * st.y * g1 + b1; }
                        if (FINAL) { *(f32x4*)(outf + off + bj * HALF + 4) = o1; }
                        else { u32x4 w; w.x = cvt_pk_bf16(o0[0], o0[1]); w.y = cvt_pk_bf16(o0[2], o0[3]); w.z = cvt_pk_bf16(o1[0], o1[1]); w.w = cvt_pk_bf16(o1[2], o1[3]); *(u32x4*)(S + off + bj * HALF) = w; }
                        asm volatile("" ::: "memory"); }
                }
        }
    }
};

template <class Epi, bool ALIGN_EPI, class Sched = Order>
__device__ __forceinline__ void gemm_phase(LAS unsigned char* lds, const Gemm g, const Sched& S, const Epi& E) {
    int tid = threadIdx.x; asm volatile("" : "+v"(tid));
    const int wid = __builtin_amdgcn_readfirstlane(tid >> 6), lane = tid & 63, wr = wid >> 2, wc = wid & 3, fr = lane & 15, fq = lane >> 4;
    int K_ = g.K; asm volatile("" : "+s"(K_));
    const int nt = K_ / BK;
    unsigned voffA[2], voffB[2];
#pragma unroll
    for (int i = 0; i < 2; ++i) { int R, C; stage_rc(tid * 16 + i * 8192, R, C); const int Rb = Epi::PERM ? ((R & ~31) + perm32(R & 31)) : R;
        voffA[i] = (unsigned)(R * g.lda + C) * 2u; voffB[i] = (unsigned)(Rb * g.ldb + C) * 2u; }
    const size_t kstep = (size_t)(BK * 2);
    const size_t hstepA = (size_t)HALF * g.lda * 2, hstepB = (size_t)HALF * g.ldb * 2;
    const unsigned ldsw = (unsigned)wid * 1024u;
    const int aoff = lds_byte(wr * 64 + fr, fq * 8), boff = lds_byte(wc * 32 + fr, fq * 8);
#define PG8_SA(b, h) (((b) * 2 + (h)) * HTB)
#define PG8_SB(b, h) ((4 + (b) * 2 + (h)) * HTB)
#define PG8_STAGE(bufoff, gbase, voff) do { _Pragma("unroll") for (int _i = 0; _i < 2; ++_i) \
        __builtin_amdgcn_global_load_lds((const unsigned*)((const char*)(gbase) + (voff)[_i]), (LAS unsigned*)(lds + (bufoff) + ldsw + _i * 8192), 16, 0, 0); } while (0)
#define PG8_LDA(dst, b, h) do { _Pragma("unroll") for (int m = 0; m < 4; ++m) _Pragma("unroll") for (int k = 0; k < 2; ++k) dst[m][k] = *(const LAS bf16x8*)(lds + PG8_SA(b, h) + aoff + m * 2048 + k * 1024); } while (0)
#define PG8_LDB(dst, b, h) do { _Pragma("unroll") for (int n = 0; n < 2; ++n) _Pragma("unroll") for (int k = 0; k < 2; ++k) dst[n][k] = *(const LAS bf16x8*)(lds + PG8_SB(b, h) + boff + n * 2048 + k * 1024); } while (0)
#define PG8_MMA(ai, bj, At, Bt) do { __builtin_amdgcn_s_setprio(1); _Pragma("unroll") for (int m = 0; m < 4; ++m) _Pragma("unroll") for (int n = 0; n < 2; ++n) _Pragma("unroll") for (int k = 0; k < 2; ++k) \
        acc[ai][bj][m][n] = __builtin_amdgcn_mfma_f32_16x16x32_bf16(Bt[n][k], At[m][k], acc[ai][bj][m][n], 0, 0, 0); __builtin_amdgcn_s_setprio(0); } while (0)
#define PG8_WAIT_V(n) asm volatile("s_waitcnt vmcnt(" #n ")" ::: "memory")
#define PG8_WAIT_L(n) asm volatile("s_waitcnt lgkmcnt(" #n ")" ::: "memory")
#define PG8_BAR __builtin_amdgcn_s_barrier()
#define PG8_SCHED __builtin_amdgcn_sched_barrier(0)
    Unit cur, nxt; int ui = 0;
    if (!S.next(0, cur)) return;
    f32x4 acc[2][2][4][2];
#pragma unroll
    for (int a = 0; a < 2; ++a)
#pragma unroll
        for (int b = 0; b < 2; ++b)
#pragma unroll
            for (int m = 0; m < 4; ++m)
#pragma unroll
                for (int n = 0; n < 2; ++n) acc[a][b][m][n] = (f32x4){0.f, 0.f, 0.f, 0.f};
    bf16x8 At[4][2], B0[2][2], B1[2][2];
    const char* cA = g.a_ptr(cur); const char* cB = g.b_ptr(cur);
    PG8_STAGE(PG8_SB(0, 0), cB, voffB); PG8_STAGE(PG8_SB(0, 1), cB + hstepB, voffB); PG8_STAGE(PG8_SA(0, 0), cA, voffA); PG8_STAGE(PG8_SA(0, 1), cA + hstepA, voffA);
    if (wr == 1) PG8_BAR;
    PG8_WAIT_V(2); PG8_BAR;
    PG8_STAGE(PG8_SB(1, 0), cB + kstep, voffB); PG8_STAGE(PG8_SA(1, 0), cA + kstep, voffA); PG8_STAGE(PG8_SB(1, 1), cB + hstepB + kstep, voffB);
    PG8_WAIT_V(6); PG8_BAR;
    for (;;) {
        const bool has_next = S.next(ui + 1, nxt);
        const char* nA = has_next ? g.a_ptr(nxt) : cA; const char* nB = has_next ? g.b_ptr(nxt) : cB;
        for (int t = 0; t < nt; t += 2) {
            const bool last = (t == nt - 2);
            const char* a1 = cA + (size_t)(t + 1) * kstep;
            const char* a2 = last ? nA : cA + (size_t)(t + 2) * kstep; const char* b2 = last ? nB : cB + (size_t)(t + 2) * kstep;
            const char* a3 = a2 + kstep; const char* b3 = b2 + kstep;
            PG8_LDB(B0, 0, 0); PG8_LDB(B1, 0, 1); PG8_SCHED; PG8_LDA(At, 0, 0); PG8_STAGE(PG8_SA(1, 1), a1 + hstepA, voffA);
            PG8_WAIT_V(8); PG8_WAIT_L(0); PG8_BAR; PG8_MMA(0, 0, At, B0); PG8_MMA(0, 1, At, B1); PG8_BAR; PG8_SCHED;
            PG8_LDA(At, 0, 1); PG8_STAGE(PG8_SB(0, 0), b2, voffB); PG8_STAGE(PG8_SB(0, 1), b2 + hstepB, voffB); PG8_STAGE(PG8_SA(0, 0), a2, voffA);
            PG8_WAIT_V(8); PG8_WAIT_L(0); PG8_BAR; PG8_MMA(1, 0, At, B0); PG8_MMA(1, 1, At, B1); PG8_BAR; PG8_SCHED;
            PG8_LDB(B0, 1, 0); PG8_LDB(B1, 1, 1); PG8_SCHED; PG8_LDA(At, 1, 0); PG8_STAGE(PG8_SA(0, 1), a2 + hstepA, voffA);
            PG8_WAIT_V(8); PG8_WAIT_L(0); PG8_BAR; PG8_MMA(0, 0, At, B0); PG8_MMA(0, 1, At, B1); PG8_BAR; PG8_SCHED;
            PG8_LDA(At, 1, 1); PG8_STAGE(PG8_SB(1, 0), b3, voffB); PG8_STAGE(PG8_SB(1, 1), b3 + hstepB, voffB); PG8_STAGE(PG8_SA(1, 0), a3, voffA);
            PG8_WAIT_V(8); PG8_WAIT_L(0); PG8_BAR; PG8_MMA(1, 0, At, B0); PG8_MMA(1, 1, At, B1); PG8_BAR; PG8_SCHED;
        }
        if constexpr (ALIGN_EPI) { if (wr == 0) PG8_BAR; }
        if constexpr (Epi::FUSED2) { if (has_next) { int fr_e = fr, fq_e = fq, tid_e = tid; asm volatile("" : "+v"(fr_e), "+v"(fq_e), "+v"(tid_e));
            E.first(acc, cur, wr, wc, fr_e, fq_e, lds + STAGE_BYTES, tid_e); } }
        else if constexpr (!Epi::AFTER_DRAIN) { E(acc, cur, wr, wc, fr, fq); }
        if (!has_next) break;
#pragma unroll
        for (int a = 0; a < 2; ++a)
#pragma unroll
            for (int b = 0; b < 2; ++b)
#pragma unroll
                for (int m = 0; m < 4; ++m)
#pragma unroll
                    for (int n = 0; n < 2; ++n) acc[a][b][m][n] = (f32x4){0.f, 0.f, 0.f, 0.f};
        cur = nxt; cA = nA; cB = nB; ++ui;
        if constexpr (ALIGN_EPI) { if (wr == 1) PG8_BAR; }
    }
    PG8_WAIT_V(0);
    if constexpr (!ALIGN_EPI) { if (wr == 0) PG8_BAR; }
    PG8_BAR;
    if constexpr (Epi::FUSED2) { int fr_e = fr, fq_e = fq, tid_e = tid; asm volatile("" : "+v"(fr_e), "+v"(fq_e), "+v"(tid_e));
        E.last(acc, cur, wr, wc, fr_e, fq_e, lds + STAGE_BYTES, tid_e, tid_e & 63, wid); }
    else if constexpr (Epi::AFTER_DRAIN) { E.fused(acc, cur, wr, wc, fr, fq, lds, wid, lane); }
#undef PG8_SA
#undef PG8_SB
#undef PG8_STAGE
#undef PG8_LDA
#undef PG8_LDB
#undef PG8_MMA
#undef PG8_WAIT_V
#undef PG8_WAIT_L
#undef PG8_BAR
#undef PG8_SCHED
}
}

#ifndef PHMASK
#define PHMASK 0xffffffffu
#endif
#define PH(k) (((PHMASK) >> (k)) & 1u)
struct Args {
    const float *x, *mem, *w_in, *conv_w, *a_log, *dt_bias, *gdn_norm_w, *pool_w, *pool_scale, *w_out, *ln1_g, *ln1_b,
                *xq_w, *xk_w, *xv_w, *xo_w, *ln2_g, *ln2_b, *w_up, *w_down, *ln3_g, *ln3_b;
    float* out; unsigned char* ws;
};

__device__ __forceinline__ void p0_transpose_item(const float* W, int ldw, int nsrc, int nblk, int K, bf16_t* WT, int ndst, LAS float* scr, int item, int lane, const float* rscale = nullptr) {
    const int kb = item / nblk, nb = item % nblk, k0 = 64 * kb, n0 = 32 * nb;
    const int kr = lane >> 3, nc = (lane & 7) * 4;
    f32x4 v[8];
#pragma unroll
    for (int i = 0; i < 8; ++i) v[i] = *(const f32x4*)(W + (size_t)(k0 + kr + 8 * i) * ldw + nsrc + n0 + nc);
#pragma unroll
    for (int i = 0; i < 8; ++i)
#pragma unroll
        for (int e = 0; e < 4; ++e) scr[(kr + 8 * i) * 33 + nc + e] = v[i][e];
    asm volatile("s_waitcnt lgkmcnt(0)" ::: "memory");
    const int c = lane & 7;
#pragma unroll
    for (int j = 0; j < 4; ++j) { const int n = (lane >> 3) + 8 * j; const LAS float* s = scr + (8 * c) * 33 + n;
        const float rs = rscale ? rscale[n0 + n] : 1.0f;
        u32x4 o; o.x = cvt_pk_bf16(s[0 * 33] * rs, s[1 * 33] * rs); o.y = cvt_pk_bf16(s[2 * 33] * rs, s[3 * 33] * rs); o.z = cvt_pk_bf16(s[4 * 33] * rs, s[5 * 33] * rs); o.w = cvt_pk_bf16(s[6 * 33] * rs, s[7 * 33] * rs);
        *(u32x4*)(WT + (size_t)(ndst + n0 + n) * K + k0 + 8 * c) = o; }
    asm volatile("s_waitcnt lgkmcnt(0)" ::: "memory");
}
__device__ __forceinline__ void cvt_flat(const float* src, bf16_t* dst, size_t n8, size_t gtid, size_t NT) {
    for (size_t i = gtid; i < n8; i += NT) { const f32x4 a = ((const f32x4*)src)[2 * i], b = ((const f32x4*)src)[2 * i + 1];
        u32x4 o; o.x = cvt_pk_bf16(a[0], a[1]); o.y = cvt_pk_bf16(a[2], a[3]); o.z = cvt_pk_bf16(b[0], b[1]); o.w = cvt_pk_bf16(b[2], b[3]); ((u32x4*)dst)[i] = o; }
}
__device__ __forceinline__ float wave_sum(float v) {
#pragma unroll
    for (int o = 1; o < 64; o <<= 1) v += __shfl_xor(v, o);
    return v;
}
template <bool FINAL>
__device__ __forceinline__ void ln_pass(bf16_t* S, float* dstf, const float* g, const float* b, int gw, int NGW, int lane) {
    for (int row = gw; row < M_TOK; row += NGW) {
        u32x4* sr = (u32x4*)(S + (size_t)row * DM) + lane;
        float v[4][8]; float s = 0.f;
#pragma unroll
        for (int j = 0; j < 4; ++j) { const u32x4 raw = sr[64 * j];
#pragma unroll
            for (int e = 0; e < 4; ++e) { v[j][2 * e] = __uint_as_float(raw[e] << 16); v[j][2 * e + 1] = __uint_as_float(raw[e] & 0xffff0000u); s += v[j][2 * e] + v[j][2 * e + 1]; } }
        const float mean = wave_sum(s) * (1.f / DM); float s2 = 0.f;
#pragma unroll
        for (int j = 0; j < 4; ++j)
#pragma unroll
            for (int e = 0; e < 8; ++e) { v[j][e] -= mean; s2 += v[j][e] * v[j][e]; }
        const float rstd = 1.0f / sqrtf(wave_sum(s2) * (1.f / DM) + LN_EPS);
#pragma unroll
        for (int j = 0; j < 4; ++j) { const int c = 8 * lane + 512 * j;
            const f32x4 g0 = *(const f32x4*)(g + c), g1 = *(const f32x4*)(g + c + 4), b0 = *(const f32x4*)(b + c), b1 = *(const f32x4*)(b + c + 4);
            float o[8];
#pragma unroll
            for (int e = 0; e < 4; ++e) { o[e] = v[j][e] * rstd * g0[e] + b0[e]; o[4 + e] = v[j][4 + e] * rstd * g1[e] + b1[e]; }
            if (FINAL) { float* d = dstf + (size_t)row * DM + c; *(f32x4*)d = (f32x4){o[0], o[1], o[2], o[3]}; *(f32x4*)(d + 4) = (f32x4){o[4], o[5], o[6], o[7]}; }
            else { u32x4 w; w.x = cvt_pk_bf16(o[0], o[1]); w.y = cvt_pk_bf16(o[2], o[3]); w.z = cvt_pk_bf16(o[4], o[5]); w.w = cvt_pk_bf16(o[6], o[7]); sr[64 * j] = w; } }
    }
}

constexpr int PL_KN = 0, PL_QS = 17408, PL_RHS = 34816, PL_LM = 68608, PL_AS = 84992, PL_KDT = 94208;
constexpr int KN_LD = 136, RHS_LD = 264, AS_LD = 72, KDT_LD = 72;
constexpr int PL_CW = 114688;
struct PrepRaw { u32x4 x[3][5]; float bb, aa; };
__device__ __forceinline__ void gdn_prep_load(const Args& a, int unit, int tid, PrepRaw& R) {
    const int lane = tid & 63, bh = unit >> 5, chunk = unit & 31, b = bh >> 3, h = bh & 7, cc = tid & 15, r0 = 2 * (tid >> 4);
    const bf16_t* QKV = (const bf16_t*)(a.ws + WS_QKV);
#pragma unroll
    for (int s = 0; s < 3; ++s)
#pragma unroll
        for (int d = 0; d < 5; ++d) { const int t = chunk * 64 + r0 + d - 3;
            R.x[s][d] = (u32x4){0u, 0u, 0u, 0u};
            if (t >= 0) R.x[s][d] = *(const u32x4*)(QKV + ((size_t)b * SEQ + t) * 3072 + s * 1024 + h * 128 + cc * 8); }
    const float* ba = (const float*)(a.ws + WS_BA) + ((size_t)b * SEQ + (size_t)chunk * 64 + lane) * 16;
    const float* ba1 = (const float*)((const unsigned char*)a.out + 112 * MiB) + ((size_t)b * SEQ + (size_t)chunk * 64 + lane) * 16;
    R.bb = ba[h] + ba1[h]; R.aa = ba[8 + h] + ba1[8 + h];
}
__device__ __forceinline__ void gdn_prep_unit(LAS unsigned char* lds, const Args& a, int unit, const PrepRaw& R, int next_unit, PrepRaw& NXT) {
    int tid = threadIdx.x; asm volatile("" : "+v"(tid));
    const int lane = tid & 63, wid = __builtin_amdgcn_readfirstlane(tid >> 6);
    const int bh = unit >> 5, chunk = unit & 31, b = bh >> 3, h = bh & 7;
    const size_t row0 = (size_t)b * SEQ + (size_t)chunk * 64;
    unsigned char* ws = a.ws;
    const bf16_t* QKV = (const bf16_t*)(ws + WS_QKV);
    LAS bf16_t* KN = (LAS bf16_t*)(lds + PL_KN); LAS bf16_t* QS = (LAS bf16_t*)(lds + PL_QS); LAS bf16_t* RHS = (LAS bf16_t*)(lds + PL_RHS);
    LAS float* LM = (LAS float*)(lds + PL_LM); LAS bf16_t* AS = (LAS bf16_t*)(lds + PL_AS); LAS bf16_t* KDT = (LAS bf16_t*)(lds + PL_KDT);
    float gcum, beta;
    {
        const float bb = R.bb, aa = R.aa;
        beta = __builtin_amdgcn_rcpf(1.0f + __expf(-bb));
        const float xx = aa + a.dt_bias[h];
        const float sp = fmaxf(xx, 0.f) + log1pf(__expf(-fabsf(xx)));
        gcum = -__expf(a.a_log[h]) * sp;
#pragma unroll
        for (int o = 1; o < 64; o <<= 1) { const float t = __shfl_up(gcum, o); if (lane >= o) gcum += t; }
    }
    const float glast = __shfl(gcum, 63);
    const int cc = tid & 15, rp = tid >> 4;
    const int r0 = 2 * rp;
    float qv[2][8], kv[2][8], vv[2][8];
#pragma unroll
    for (int s = 0; s < 3; ++s) {
        const int col = s * 1024 + h * 128 + cc * 8;
        float xin[5][8];
#pragma unroll
        for (int d = 0; d < 5; ++d) { const int t = chunk * 64 + r0 + d - 3;
            const u32x4 raw = R.x[s][d]; (void)t;
#pragma unroll
            for (int e = 0; e < 4; ++e) { xin[d][2 * e] = __uint_as_float(raw[e] << 16); xin[d][2 * e + 1] = __uint_as_float(raw[e] & 0xffff0000u); } }
        float cw[4][8];
#pragma unroll
        for (int j = 0; j < 4; ++j) { const LAS float* cwp = (const LAS float*)(lds + PL_CW) + (s * 4 + j) * 128 + cc * 8; const f32x4 w0 = *(const LAS f32x4*)cwp, w1 = *(const LAS f32x4*)(cwp + 4);
#pragma unroll
            for (int e = 0; e < 4; ++e) { cw[j][e] = w0[e]; cw[j][4 + e] = w1[e]; } }
#pragma unroll
        for (int r = 0; r < 2; ++r)
#pragma unroll
            for (int e = 0; e < 8; ++e) { float acc = 0.f;
#pragma unroll
                for (int j = 0; j < 4; ++j) acc += cw[j][e] * xin[r + j][e];
                const float y = silu_f(acc);
                if (s == 0) qv[r][e] = y; else if (s == 1) kv[r][e] = y; else vv[r][e] = y; }
    }
#pragma unroll
    for (int r = 0; r < 2; ++r) { float sq = 0.f, sk = 0.f;
#pragma unroll
        for (int e = 0; e < 8; ++e) { sq += qv[r][e] * qv[r][e]; sk += kv[r][e] * kv[r][e]; }
        sq = row16_sum(sq); sk = row16_sum(sk);
        const float rq = __builtin_amdgcn_rsqf(sq + NORM_EPS) * 0.08838834764831845f, rk = __builtin_amdgcn_rsqf(sk + NORM_EPS);
#pragma unroll
        for (int e = 0; e < 8; ++e) { qv[r][e] *= rq; kv[r][e] *= rk; } }
    {
        float gi[2], bi[2];
#pragma unroll
        for (int r = 0; r < 2; ++r) { gi[r] = __shfl(gcum, r0 + r); bi[r] = __shfl(beta, r0 + r); }
        bf16_t* QGo = (bf16_t*)(ws + WS_QG) + (size_t)unit * 8192;
#pragma unroll
        for (int r = 0; r < 2; ++r) { const int i = r0 + r; const float eg = __expf(gi[r]), ed = __expf(glast - gi[r]);
            u32x4 w;
            w.x = cvt_pk_bf16(kv[r][0], kv[r][1]); w.y = cvt_pk_bf16(kv[r][2], kv[r][3]); w.z = cvt_pk_bf16(kv[r][4], kv[r][5]); w.w = cvt_pk_bf16(kv[r][6], kv[r][7]);
            *(LAS u32x4*)(KN + i * KN_LD + cc * 8) = w;
            w.x = cvt_pk_bf16(qv[r][0], qv[r][1]); w.y = cvt_pk_bf16(qv[r][2], qv[r][3]); w.z = cvt_pk_bf16(qv[r][4], qv[r][5]); w.w = cvt_pk_bf16(qv[r][6], qv[r][7]);
            *(LAS u32x4*)(QS + i * KN_LD + cc * 8) = w;
            const float bv_ = bi[r];
            w.x = cvt_pk_bf16(vv[r][0] * bv_, vv[r][1] * bv_); w.y = cvt_pk_bf16(vv[r][2] * bv_, vv[r][3] * bv_); w.z = cvt_pk_bf16(vv[r][4] * bv_, vv[r][5] * bv_); w.w = cvt_pk_bf16(vv[r][6] * bv_, vv[r][7] * bv_);
            *(LAS u32x4*)(RHS + i * RHS_LD + cc * 8) = w;
            const float bk = bi[r] * eg;
            w.x = cvt_pk_bf16(kv[r][0] * bk, kv[r][1] * bk); w.y = cvt_pk_bf16(kv[r][2] * bk, kv[r][3] * bk); w.z = cvt_pk_bf16(kv[r][4] * bk, kv[r][5] * bk); w.w = cvt_pk_bf16(kv[r][6] * bk, kv[r][7] * bk);
            *(LAS u32x4*)(RHS + i * RHS_LD + 128 + cc * 8) = w;
            w.x = cvt_pk_bf16(qv[r][0] * eg, qv[r][1] * eg); w.y = cvt_pk_bf16(qv[r][2] * eg, qv[r][3] * eg); w.z = cvt_pk_bf16(qv[r][4] * eg, qv[r][5] * eg); w.w = cvt_pk_bf16(qv[r][6] * eg, qv[r][7] * eg);
            *(u32x4*)(QGo + (size_t)i * 128 + cc * 8) = w;
#pragma unroll
            for (int e = 0; e < 8; ++e) kv[r][e] *= ed;
        }
#pragma unroll
        for (int e = 0; e < 8; ++e) *(LAS unsigned*)(KDT + (cc * 8 + e) * KDT_LD + r0) = cvt_pk_bf16(kv[0][e], kv[1][e]);
        if (tid == 0) ((float*)(ws + WS_GL))[(size_t)unit * 32] = __expf(glast);
    }
    LDS_BARRIER();
    {
        const int which = wid >> 2, mi = wid & 3, fr = lane & 15, fq = lane >> 4;
        LAS bf16_t* Asrc = which ? QS : KN;
        bf16x8 af[4];
#pragma unroll
        for (int kk = 0; kk < 4; ++kk) af[kk] = *(const LAS bf16x8*)(Asrc + (mi * 16 + fr) * KN_LD + kk * 32 + fq * 8);
        float gi4[4], bi4[4];
#pragma unroll
        for (int jj = 0; jj < 4; ++jj) { gi4[jj] = __shfl(gcum, mi * 16 + fq * 4 + jj); bi4[jj] = __shfl(beta, mi * 16 + fq * 4 + jj); }
#pragma unroll
        for (int ni = 0; ni < 4; ++ni) {
            const float gj = __shfl(gcum, ni * 16 + fr);
            f32x4 acc = (f32x4){0.f, 0.f, 0.f, 0.f};
            if (ni <= mi) {
#pragma unroll
                for (int kk = 0; kk < 4; ++kk) { const bf16x8 bfrag = *(const LAS bf16x8*)(KN + (ni * 16 + fr) * KN_LD + kk * 32 + fq * 8);
                    acc = __builtin_amdgcn_mfma_f32_16x16x32_bf16(af[kk], bfrag, acc, 0, 0, 0); }
            }
            const int j = ni * 16 + fr;
#pragma unroll
            for (int jj = 0; jj < 4; ++jj) { const int i = mi * 16 + fq * 4 + jj;
                const float dec = (i >= j) ? __expf(gi4[jj] - gj) : 0.f;
                if (which == 0) LM[i * 64 + j] = (i > j) ? bi4[jj] * acc[jj] * dec : 0.f;
                else AS[i * AS_LD + j] = (bf16_t)(cvt_pk_bf16(acc[jj] * dec, 0.f) & 0xffffu); }
        }
    }
    LDS_BARRIER();
    gdn_prep_load(a, next_unit, tid, NXT);
    if (wid < 4) {
        const int c = tid;
        int vz; asm volatile("v_mov_b32 %0, 0" : "=v"(vz));
        const LAS float* LMv = LM + vz;
        f32x2 X2[32];
#pragma unroll
        for (int i = 0; i < 64; ++i) {
            float r = bf2f((unsigned)RHS[i * RHS_LD + c]);
            f32x2 pa = (f32x2){0.f, 0.f}, pb = (f32x2){0.f, 0.f};
#pragma unroll
            for (int j4 = 0; j4 < (i + 3) / 4; ++j4) { const f32x4 l = *(const LAS f32x4*)(LMv + i * 64 + j4 * 4);
                if (j4 * 4 + 1 < i) pa = (f32x2){l[0], l[1]} * X2[j4 * 2] + pa;
                else if (j4 * 4 < i) pa.x += l[0] * X2[j4 * 2].x;
                if (j4 * 4 + 3 < i) pb = (f32x2){l[2], l[3]} * X2[j4 * 2 + 1] + pb;
                else if (j4 * 4 + 2 < i) pb.x += l[2] * X2[j4 * 2 + 1].x; }
            r -= (pa.x + pa.y) + (pb.x + pb.y);
            if (i & 1) X2[i >> 1].y = r; else X2[i >> 1].x = r;
            if (c >= 128) RHS[i * RHS_LD + c] = (bf16_t)(cvt_pk_bf16(r, 0.f) & 0xffffu);
        }
        if (c < 128) {
            bf16_t* UTo = (bf16_t*)(ws + WS_UT) + (size_t)unit * 8192 + (size_t)c * 64;
#pragma unroll
            for (int q8 = 0; q8 < 8; ++q8) { u32x4 w; w.x = cvt_pk_bf16(X2[q8 * 4 + 0].x, X2[q8 * 4 + 0].y); w.y = cvt_pk_bf16(X2[q8 * 4 + 1].x, X2[q8 * 4 + 1].y); w.z = cvt_pk_bf16(X2[q8 * 4 + 2].x, X2[q8 * 4 + 2].y); w.w = cvt_pk_bf16(X2[q8 * 4 + 3].x, X2[q8 * 4 + 3].y);
                *(u32x4*)(UTo + q8 * 8) = w; }
        }
    } else {
        const int t2 = tid - 256;
        bf16_t* AIo = (bf16_t*)(ws + WS_AI) + (size_t)unit * 4096; bf16_t* KDo = (bf16_t*)(ws + WS_KDT) + (size_t)unit * 8192;
#pragma unroll
        for (int p = 0; p < 2; ++p) { const int piece = t2 + 256 * p, r = piece >> 3, cseg = piece & 7;
            *(u32x4*)(AIo + r * 64 + cseg * 8) = *(const LAS u32x4*)(AS + r * AS_LD + cseg * 8); }
#pragma unroll
        for (int p = 0; p < 4; ++p) { const int piece = t2 + 256 * p, r = piece >> 3, cseg = piece & 7;
            *(u32x4*)(KDo + r * 64 + cseg * 8) = *(const LAS u32x4*)(KDT + r * KDT_LD + cseg * 8); }
    }
    LDS_BARRIER();
    {
        bf16_t* Wo = (bf16_t*)(ws + WS_W) + (size_t)unit * 8192;
#pragma unroll
        for (int p = 0; p < 2; ++p) { const int piece = tid + 512 * p, r = piece >> 4, cseg = piece & 15;
            *(u32x4*)(Wo + r * 128 + cseg * 8) = *(const LAS u32x4*)(RHS + r * RHS_LD + 128 + cseg * 8); }
    }
    LDS_BARRIER();
}

constexpr int SL_SBT = 0, SL_VNT = 34816, SL_RED = 34816 + 18432;
constexpr int SBT_LD = 136, VNT_LD = 72;
constexpr int SL_OST = 53760, OST_LD = 68;
__device__ __forceinline__ void gdn_scan(LAS unsigned char* lds, const Args& a, int bh) {
    int tid = threadIdx.x; asm volatile("" : "+v"(tid));
    const int lane = tid & 63, wid = __builtin_amdgcn_readfirstlane(tid >> 6), fr = lane & 15, fq = lane >> 4;
    const int it = wid & 3, vh = wid >> 2, kt0 = 2 * (wid & 3);
    const int b = bh >> 3, h = bh & 7;
    unsigned char* ws = a.ws;
    LAS bf16_t* SBT = (LAS bf16_t*)(lds + SL_SBT); LAS bf16_t* VNT = (LAS bf16_t*)(lds + SL_VNT); LAS float* RED = (LAS float*)(lds + SL_RED);
    const bf16_t* Wg = (const bf16_t*)(ws + WS_W); const bf16_t* QG = (const bf16_t*)(ws + WS_QG); const bf16_t* AI = (const bf16_t*)(ws + WS_AI);
    const bf16_t* KD = (const bf16_t*)(ws + WS_KDT); const bf16_t* UT = (const bf16_t*)(ws + WS_UT); const float* GL = (const float*)(ws + WS_GL);
    const bf16_t* Z = (const bf16_t*)(ws + WS_Z); bf16_t* MIX = (bf16_t*)((unsigned char*)a.out + 32 * MiB);
    for (int i = tid; i < (34816 + 18432) / 4; i += 512) ((LAS unsigned*)lds)[i] = 0u;
    f32x4 S[2][4];
#pragma unroll
    for (int t = 0; t < 2; ++t)
#pragma unroll
        for (int vt = 0; vt < 4; ++vt) S[t][vt] = (f32x4){0.f, 0.f, 0.f, 0.f};
    LAS float* OST = (LAS float*)(lds + SL_OST + wid * (16 * OST_LD * 4));
    const int orow_l = lane >> 2, oseg = lane & 3;
    f32x4 nw4[4];
#pragma unroll
    for (int q = 0; q < 4; ++q) nw4[q] = *(const f32x4*)(a.gdn_norm_w + vh * 64 + oseg * 16 + q * 4);
    LDS_BARRIER();
    bf16x8 wA[4], qA[4], aA[2], kA[2][2]; u32x2 uu[4]; u32x4 z0, z1; float egl;
#define SCAN_LOAD1(U) do { _Pragma("unroll") for (int kk = 0; kk < 4; ++kk) { wA[kk] = *(const bf16x8*)(Wg + (U) * 8192 + (it * 16 + fr) * 128 + kk * 32 + fq * 8); qA[kk] = *(const bf16x8*)(QG + (U) * 8192 + (it * 16 + fr) * 128 + kk * 32 + fq * 8); } \
        _Pragma("unroll") for (int vt = 0; vt < 4; ++vt) uu[vt] = *(const u32x2*)(UT + (U) * 8192 + (size_t)(vh * 64 + vt * 16 + fr) * 64 + it * 16 + fq * 4); } while (0)
#define SCAN_LOAD2(U) do { _Pragma("unroll") for (int k2 = 0; k2 < 2; ++k2) { aA[k2] = *(const bf16x8*)(AI + (U) * 4096 + (it * 16 + fr) * 64 + k2 * 32 + fq * 8); \
            _Pragma("unroll") for (int t = 0; t < 2; ++t) kA[t][k2] = *(const bf16x8*)(KD + (U) * 8192 + ((kt0 + t) * 16 + fr) * 64 + k2 * 32 + fq * 8); } \
        egl = GL[(U) * 32]; } while (0)
#define SCAN_LOADZ(N) do { const size_t zr_ = (size_t)b * SEQ + (size_t)(N) * 64 + it * 16 + orow_l; z0 = *(const u32x4*)(Z + zr_ * 1024 + h * 128 + vh * 64 + oseg * 16); z1 = *(const u32x4*)(Z + zr_ * 1024 + h * 128 + vh * 64 + oseg * 16 + 8); } while (0)
    { const size_t u0_ = (size_t)bh * 32; SCAN_LOAD1(u0_); SCAN_LOAD2(u0_); SCAN_LOADZ(0); }
#pragma unroll 2
    for (int n = 0; n < NCHUNK; ++n) {
        if (n == LATE0 - 2) {
            if (tid == 0) { unsigned sp = 0u; while (__hip_atomic_load((unsigned*)(ws + WS_FLAGS) + 64 * bh, __ATOMIC_RELAXED, __HIP_MEMORY_SCOPE_AGENT) == 0u) { __builtin_amdgcn_s_sleep(4); if (++sp > (1u << 22)) break; }
                __builtin_amdgcn_fence(__ATOMIC_ACQUIRE, "agent"); asm volatile("s_waitcnt vmcnt(0)" ::: "memory"); }
            LDS_BARRIER();
        }
        const size_t unit = (size_t)bh * 32 + n;
        const size_t un = (n + 1 < NCHUNK) ? unit + 1 : unit;
        const int nn = (n + 1 < NCHUNK) ? n + 1 : n;
        const size_t orow = (size_t)b * SEQ + (size_t)n * 64 + it * 16 + orow_l;
        asm volatile("" : "+v"(uu[0]), "+v"(uu[1]), "+v"(uu[2]), "+v"(uu[3]));
        f32x4 accO[4];
        {
            bf16x8 bfr[4][4];
#pragma unroll
            for (int vt = 0; vt < 4; ++vt)
#pragma unroll
                for (int kk = 0; kk < 4; ++kk) bfr[vt][kk] = *(const LAS bf16x8*)(SBT + (vh * 64 + vt * 16 + fr) * SBT_LD + kk * 32 + fq * 8);
#pragma unroll
            for (int vt = 0; vt < 4; ++vt) {
                f32x4 accF = (f32x4){0.f, 0.f, 0.f, 0.f}; accO[vt] = (f32x4){0.f, 0.f, 0.f, 0.f};
#pragma unroll
                for (int kk = 0; kk < 4; ++kk) {
                    accF = __builtin_amdgcn_mfma_f32_16x16x32_bf16(wA[kk], bfr[vt][kk], accF, 0, 0, 0);
                    accO[vt] = __builtin_amdgcn_mfma_f32_16x16x32_bf16(qA[kk], bfr[vt][kk], accO[vt], 0, 0, 0); }
                const float u0 = __uint_as_float(uu[vt].x << 16), u1 = __uint_as_float(uu[vt].x & 0xffff0000u), u2 = __uint_as_float(uu[vt].y << 16), u3 = __uint_as_float(uu[vt].y & 0xffff0000u);
                u32x2 w; w.x = cvt_pk_bf16(u0 - accF[0], u1 - accF[1]); w.y = cvt_pk_bf16(u2 - accF[2], u3 - accF[3]);
                *(LAS u32x2*)(VNT + (vh * 64 + vt * 16 + fr) * VNT_LD + it * 16 + fq * 4) = w;
            }
        }
        asm volatile("" ::: "memory");
        SCAN_LOAD1(un);
        LDS_BARRIER();
        asm volatile("" : "+v"(egl));
        {
            bf16x8 vb[4][2];
#pragma unroll
            for (int vt = 0; vt < 4; ++vt)
#pragma unroll
                for (int k2 = 0; k2 < 2; ++k2) vb[vt][k2] = *(const LAS bf16x8*)(VNT + (vh * 64 + vt * 16 + fr) * VNT_LD + k2 * 32 + fq * 8);
#pragma unroll
            for (int vt = 0; vt < 4; ++vt) {
#pragma unroll
                for (int k2 = 0; k2 < 2; ++k2) accO[vt] = __builtin_amdgcn_mfma_f32_16x16x32_bf16(aA[k2], vb[vt][k2], accO[vt], 0, 0, 0);
#pragma unroll
                for (int t = 0; t < 2; ++t) { f32x4 sv = S[t][vt] * egl;
#pragma unroll
                    for (int k2 = 0; k2 < 2; ++k2) sv = __builtin_amdgcn_mfma_f32_16x16x32_bf16(kA[t][k2], vb[vt][k2], sv, 0, 0, 0);
                    S[t][vt] = sv;
                    u32x2 w; w.x = cvt_pk_bf16(sv[0], sv[1]); w.y = cvt_pk_bf16(sv[2], sv[3]);
                    *(LAS u32x2*)(SBT + (vh * 64 + vt * 16 + fr) * SBT_LD + (kt0 + t) * 16 + fq * 4) = w; }
            }
        }
        {
            float ss[4];
#pragma unroll
            for (int jj = 0; jj < 4; ++jj) { float s = 0.f;
#pragma unroll
                for (int vt = 0; vt < 4; ++vt) s += accO[vt][jj] * accO[vt][jj];
                s = row16_sum(s);
                ss[jj] = s; }
            if (fr == 0) {
#pragma unroll
                for (int jj = 0; jj < 4; ++jj) RED[(it * 16 + fq * 4 + jj) * 2 + vh] = ss[jj]; }
        }
        asm volatile("" ::: "memory");
        SCAN_LOAD2(un);
        LDS_BARRIER();
        asm volatile("" : "+v"(z0), "+v"(z1));
#pragma unroll
        for (int jj = 0; jj < 4; ++jj) { const f32x2 rr = *(const LAS f32x2*)(RED + (it * 16 + fq * 4 + jj) * 2);
            const float rstd = __builtin_amdgcn_rsqf((rr.x + rr.y) * (1.0f / 128.0f) + NORM_EPS);
#pragma unroll
            for (int vt = 0; vt < 4; ++vt) OST[(fq * 4 + jj) * OST_LD + vt * 16 + fr] = accO[vt][jj] * rstd; }
        asm volatile("s_waitcnt lgkmcnt(0)" ::: "memory");
        {
            f32x4 ov[4];
#pragma unroll
            for (int q = 0; q < 4; ++q) ov[q] = *(const LAS f32x4*)(OST + orow_l * OST_LD + oseg * 16 + q * 4) * nw4[q];
            float zf[16];
#pragma unroll
            for (int e = 0; e < 4; ++e) { zf[2 * e] = __uint_as_float(z0[e] << 16); zf[2 * e + 1] = __uint_as_float(z0[e] & 0xffff0000u); zf[8 + 2 * e] = __uint_as_float(z1[e] << 16); zf[8 + 2 * e + 1] = __uint_as_float(z1[e] & 0xffff0000u); }
            float of[16];
#pragma unroll
            for (int q = 0; q < 4; ++q)
#pragma unroll
                for (int e = 0; e < 4; ++e) of[q * 4 + e] = ov[q][e] * silu_f(zf[q * 4 + e]);
            u32x4 w0, w1;
            w0.x = cvt_pk_bf16(of[0], of[1]); w0.y = cvt_pk_bf16(of[2], of[3]); w0.z = cvt_pk_bf16(of[4], of[5]); w0.w = cvt_pk_bf16(of[6], of[7]);
            w1.x = cvt_pk_bf16(of[8], of[9]); w1.y = cvt_pk_bf16(of[10], of[11]); w1.z = cvt_pk_bf16(of[12], of[13]); w1.w = cvt_pk_bf16(of[14], of[15]);
            bf16_t* mp = MIX + orow * 2048 + h * 128 + vh * 64 + oseg * 16;
            *(u32x4*)mp = w0; *(u32x4*)(mp + 8) = w1;
        }
        asm volatile("s_waitcnt lgkmcnt(0)" ::: "memory");
        SCAN_LOADZ(nn);
    }
    LDS_BARRIER();
}


#define XB_TMO      128
#define XB_XCNT(j)  (256  + 64 * (j))
#define XB_XSUB(j)  (1280 + 64 * (j))
#define XB_XGEN(j)  (2304 + 64 * (j))
#define XB_TOP      3328
#define XB_TOPGEN   3392
#define XCD_BAR_WORDS 3456
#define XB_SPIN_CAP (1u << 20)
__device__ __forceinline__ unsigned xb_ld(unsigned* p)              { return __hip_atomic_load(p, __ATOMIC_RELAXED, __HIP_MEMORY_SCOPE_AGENT); }
__device__ __forceinline__ unsigned xb_add(unsigned* p, unsigned v) { return __hip_atomic_fetch_add(p, v, __ATOMIC_RELAXED, __HIP_MEMORY_SCOPE_AGENT); }
__device__ __forceinline__ unsigned xb_xcc_id() { return (unsigned)__builtin_amdgcn_s_getreg((3 << 11) | 20) & 0xFu; }
#define XB_SPIN(cond, bar) do { unsigned _sp = 0; while (cond) { __builtin_amdgcn_s_sleep(1); \
    if ((++_sp & 255u) == 0u) { if (xb_ld(&(bar)[XB_TMO])) break; if (_sp > XB_SPIN_CAP) { atomicAdd(&(bar)[XB_TMO], 1u); break; } } } } while (0)
struct XcdBarrier { unsigned* bar; unsigned x; volatile LAS unsigned* st; };
__device__ __forceinline__ XcdBarrier xcd_barrier_post(unsigned* bar, volatile LAS unsigned* st) {
    XcdBarrier b; b.bar = bar; b.x = xb_xcc_id(); b.st = st;
    if (threadIdx.x == 0) (void)xb_add(&bar[XB_XCNT(b.x)], 1u);
    return b;
}
__device__ __forceinline__ void xcd_barrier_complete(unsigned* bar, unsigned x, unsigned& nloc, unsigned& nx) {
    const unsigned G = gridDim.x * gridDim.y * gridDim.z;
    unsigned sum, cnt, mine, sp = 0u;
    for (;;) {
        sum = 0u; cnt = 0u; mine = 0u;
#pragma unroll
        for (unsigned j = 0; j < 16; ++j) { const unsigned c = xb_ld(&bar[XB_XCNT(j)]); sum += c; cnt += (c > 0u) ? 1u : 0u; mine = (j == x) ? c : mine; }
        if (sum == G) break;
        __builtin_amdgcn_s_sleep(1);
        if ((++sp & 255u) == 0u) { if (xb_ld(&bar[XB_TMO])) break; if (sp > XB_SPIN_CAP) { atomicAdd(&bar[XB_TMO], 1u); break; } }
    }
    nloc = mine > 0u ? mine : 1u; nx = cnt > 0u ? cnt : 1u;
}
__device__ __forceinline__ void xcd_barrier(const XcdBarrier& b) {
    asm volatile("s_waitcnt vmcnt(0)" ::: "memory");
    __syncthreads();
    if (threadIdx.x == 0) {
        unsigned* bar = b.bar;
        __builtin_amdgcn_s_waitcnt(0);
        unsigned nloc = b.st[0], nx = b.st[1];
        if (nloc == 0u) { xcd_barrier_complete(bar, b.x, nloc, nx); b.st[0] = nloc; b.st[1] = nx; }
        const unsigned old = xb_add(&bar[XB_XSUB(b.x)], 1u);
        const unsigned gen = old / nloc;
        if (old + 1u == (gen + 1u) * nloc) {
            __builtin_amdgcn_fence(__ATOMIC_RELEASE, "agent");
            asm volatile("s_waitcnt vmcnt(0)" ::: "memory");
            const unsigned og = xb_add(&bar[XB_TOP], 1u);
            const unsigned tg = og / nx;
            if (og + 1u == (tg + 1u) * nx) xb_add(&bar[XB_TOPGEN], 1u);
            else XB_SPIN(xb_ld(&bar[XB_TOPGEN]) == tg, bar);
            __builtin_amdgcn_fence(__ATOMIC_ACQUIRE, "agent");
            xb_add(&bar[XB_XGEN(b.x)], 1u);
            asm volatile("s_waitcnt vmcnt(0)" ::: "memory");
        } else {
            XB_SPIN(xb_ld(&bar[XB_XGEN(b.x)]) == gen, bar);
            __builtin_amdgcn_fence(__ATOMIC_ACQUIRE, "agent");
            asm volatile("s_waitcnt vmcnt(0)" ::: "memory");
        }
    }
    __syncthreads();
}

__global__ void __launch_bounds__(512, 2) hybrid_fwd(Args a) {
    extern __shared__ __attribute__((aligned(16))) unsigned char lds_raw[];
    LAS unsigned char* lds = (LAS unsigned char*)lds_raw;
    const int tid = threadIdx.x, lane = tid & 63, wave = __builtin_amdgcn_readfirstlane(tid >> 6);
    const int G = gridDim.x, bid = blockIdx.x;
    const int gw = bid * 8 + wave, NGW = G * 8;
    const size_t gtid = (size_t)bid * 512 + tid, NT = (size_t)G * 512;
    unsigned char* ws = a.ws;
    volatile LAS unsigned* MISC = (volatile LAS unsigned*)(lds + 143 * 1024);
    if (tid < 2) MISC[tid] = 0u;
    __syncthreads();
    const XcdBarrier gbar = xcd_barrier_post((unsigned*)(ws + WS_CTL), MISC);
#define GRID_SYNC() xcd_barrier(gbar)
#define WUP ((bf16_t*)(ws + WS_WUP))
#define WDN ((bf16_t*)(ws + WS_WDN))
#define WIN ((bf16_t*)(ws + WS_WIN))
#define WOUT ((bf16_t*)(ws + WS_WOUT))
#define WQ ((bf16_t*)(ws + WS_WQ))
#define WK ((bf16_t*)(ws + WS_WK))
#define WV ((bf16_t*)(ws + WS_WV))
#define WO ((bf16_t*)(ws + WS_WO))
#define WPOOL ((bf16_t*)(ws + WS_WPOOL))
#define WBA ((bf16_t*)(ws + WS_WBA))
#define XB ((bf16_t*)(ws + WS_XB))
#define MEMB ((bf16_t*)(ws + WS_MEMB))
#define HB ((bf16_t*)(ws + WS_HB))
#define STATS ((float*)(ws + WS_STATS))

    {
        LAS float* scr = (LAS float*)(lds + wave * 16384);
        constexpr int I_IN0 = 32 * 128, I_IN1 = 32 * 32, I_PL = 4 * 8;
        constexpr int NITEMS = I_IN0 + I_IN1 + 4 * I_PL;
        for (int it = gw; it < NITEMS; it += NGW) {
            int r = it;
            if (r < I_IN0) { p0_transpose_item(a.w_in, W_INLD, 0, 128, 2048, WIN, 0, scr, r, lane); continue; } r -= I_IN0;
            if (r < I_IN1) { p0_transpose_item(a.w_in, W_INLD, 4112, 32, 2048, WIN, 4096, scr, r, lane); continue; } r -= I_IN1;
            const int gpool = r / I_PL; r -= gpool * I_PL;
            p0_transpose_item(a.pool_w + (size_t)gpool * 65536, 256, 0, 8, 256, WPOOL + (size_t)gpool * 65536, 0, scr, r, lane, a.pool_scale + gpool * 256);
        }
        for (size_t e = gtid; e < 16 * 2048; e += NT) { const int n = (int)(e >> 11), k = (int)(e & 2047); WBA[e] = (bf16_t)(cvt_pk_bf16(a.w_in[(size_t)k * W_INLD + 4096 + n], 0.f) & 0xffffu); }
        cvt_flat(a.x, XB, (size_t)M_TOK * DM / 8, gtid, NT);
    }
    GRID_SYNC();

    {
        {
            const int unit = (wave & 3) * G + bid, khalf = wave >> 2;
            if (unit < M_TOK / 16) {
                const int fr = lane & 15, fq = lane >> 4;
                f32x4 acc = (f32x4){0.f, 0.f, 0.f, 0.f};
                const bf16_t* ap = XB + (size_t)(unit * 16 + fr) * DM + khalf * 1024 + fq * 8; const bf16_t* bp = WBA + (size_t)fr * DM + khalf * 1024 + fq * 8;
#pragma unroll 16
                for (int kk = 0; kk < 32; ++kk) { const bf16x8 af = *(const bf16x8*)(ap + kk * 32), bf = *(const bf16x8*)(bp + kk * 32);
                    acc = __builtin_amdgcn_mfma_f32_16x16x32_bf16(af, bf, acc, 0, 0, 0); }
                float* ba = khalf ? (float*)((unsigned char*)a.out + 112 * MiB) : (float*)(ws + WS_BA);
#pragma unroll
                for (int j = 0; j < 4; ++j) ba[(size_t)(unit * 16 + fq * 4 + j) * 16 + fr] = acc[j];
            }
        }
        __syncthreads();
        pg8::Gemm g{XB, WIN, DM, DM, DM, 0, 0, 0, 0}; pg8::Order S; S.init(M_TOK / 256, 5120 / 256, 1, 1, G, bid);
        typedef pg8::EpiBf16<0, pg8::MapG1> E1; E1 E{pg8::MapG1{(bf16_t*)(ws + WS_QKV), (bf16_t*)(ws + WS_Z), (bf16_t*)(ws + WS_P)}, 1.f};
        if (PH(1)) pg8::gemm_phase<E1, true>(lds, g, S, E);
    }
    GRID_SYNC();

    {
#ifndef NO_PREP
        {
            {
                LAS float* scr = (LAS float*)(lds + wave * 16384);
                constexpr int I_SQ = 32 * 64;
                for (int it = gw; it < 2 * I_SQ; it += NGW) {
                    if (it < I_SQ) p0_transpose_item(a.xk_w, 2048, 0, 64, 2048, WK, 0, scr, it, lane);
                    else p0_transpose_item(a.xv_w, 2048, 0, 64, 2048, WV, 0, scr, it - I_SQ, lane); }
                cvt_flat(a.mem, MEMB, (size_t)2048 * DM / 8, gtid, NT);
                __syncthreads();
            }
            if (tid < 384) { const int sq = tid >> 7, ch = tid & 127, h0 = (bid >> 5) & 7;
#pragma unroll
                for (int j = 0; j < 4; ++j) ((LAS float*)(lds + PL_CW))[(sq * 4 + j) * 128 + ch] = a.conv_w[(size_t)j * 3072 + sq * 1024 + h0 * 128 + ch]; }
            __syncthreads();
            const int h0_ = (bid >> 5) & 7, j0_ = bid & 31;
#define EARLY_UNIT(T) ((((T) / LATE0) * 8 + h0_) * 32 + ((T) % LATE0))
            PrepRaw cur, nxt;
            gdn_prep_load(a, EARLY_UNIT(j0_), tid, cur);
            for (int t = j0_; t < 8 * LATE0; t += 32) {
                const int tn = (t + 32 < 8 * LATE0) ? t + 32 : t;
                gdn_prep_unit(lds, a, EARLY_UNIT(t), cur, EARLY_UNIT(tn), nxt);
                cur = nxt;
            }
#undef EARLY_UNIT
        }
#endif
        const bf16_t* PP = (const bf16_t*)(ws + WS_P); bf16_t* PO = (bf16_t*)a.out;
        for (size_t idx = gtid; idx < (size_t)M_TOK * 128; idx += NT) {
            const size_t row = idx >> 7; const int ch = (int)(idx & 127), gi = ch >> 5, win = 2 << gi, t = (int)(row & 2047);
            const int n = (t + 1 < win) ? t + 1 : win;
            float s[8], c0[8];
#pragma unroll
            for (int e = 0; e < 8; ++e) s[e] = 0.f;
            u32x4 raw[16];
#pragma unroll
            for (int k = 0; k < 16; ++k) { raw[k] = (u32x4){0u, 0u, 0u, 0u}; if (k < n) raw[k] = *(const u32x4*)(PP + (row - k) * 1024 + ch * 8); }
#pragma unroll
            for (int k = 0; k < 16; ++k)
#pragma unroll
                for (int e = 0; e < 4; ++e) { const float lo = __uint_as_float(raw[k][e] << 16), hi = __uint_as_float(raw[k][e] & 0xffff0000u); s[2 * e] += lo; s[2 * e + 1] += hi; if (k == 0) { c0[2 * e] = lo; c0[2 * e + 1] = hi; } }
            const float inv = 1.0f / (float)n;
            u32x4 w; w.x = cvt_pk_bf16(s[0] * inv - c0[0], s[1] * inv - c0[1]); w.y = cvt_pk_bf16(s[2] * inv - c0[2], s[3] * inv - c0[3]);
            w.z = cvt_pk_bf16(s[4] * inv - c0[4], s[5] * inv - c0[5]); w.w = cvt_pk_bf16(s[6] * inv - c0[6], s[7] * inv - c0[7]);
            *(u32x4*)(PO + row * 1024 + ch * 8) = w;
        }
    }
    GRID_SYNC();

    {
#ifndef NO_SCAN
        if (bid < 64) gdn_scan(lds, a, bid);
        else
#endif
        if (bid < 128) {
            pg8::Gemm g{MEMB, WK, DM, DM, DM, 0, 0, 0, 0}; pg8::Order S; S.init(8, 8, 1, 1, 64, bid - 64);
            typedef pg8::EpiBf16<0, pg8::MapPlain> E1; E1 E{pg8::MapPlain{(bf16_t*)((unsigned char*)a.out + 96 * MiB), 2048}, 1.f};
            if (PH(2)) pg8::gemm_phase<E1, true>(lds, g, S, E);
        } else if (bid < 192) {
            pg8::Gemm g{MEMB, WV, DM, DM, DM, 0, 0, 0, 0}; pg8::Order S; S.init(8, 8, 1, 1, 64, bid - 128);
            typedef pg8::EpiBf16<0, pg8::MapPlain> E1; E1 E{pg8::MapPlain{(bf16_t*)((unsigned char*)a.out + 104 * MiB), 2048}, 1.f};
            if (PH(3)) pg8::gemm_phase<E1, true>(lds, g, S, E);
        } else {
#ifndef NO_PREP
            {
                const int bhl = bid - 192;
                __syncthreads();
                if (tid < 384) { const int sq = tid >> 7, ch = tid & 127, hl = bhl & 7;
#pragma unroll
                    for (int j = 0; j < 4; ++j) ((LAS float*)(lds + PL_CW))[(sq * 4 + j) * 128 + ch] = a.conv_w[(size_t)j * 3072 + sq * 1024 + hl * 128 + ch]; }
                __syncthreads();
                PrepRaw cur, nxt;
                gdn_prep_load(a, bhl * 32 + LATE0, tid, cur);
                for (int c = LATE0; c < NCHUNK; ++c) { const int cn = (c + 1 < NCHUNK) ? c + 1 : c;
                    gdn_prep_unit(lds, a, bhl * 32 + c, cur, bhl * 32 + cn, nxt); cur = nxt; }
                asm volatile("s_waitcnt vmcnt(0)" ::: "memory"); __syncthreads();
                if (tid == 0) { __builtin_amdgcn_fence(__ATOMIC_RELEASE, "agent"); asm volatile("s_waitcnt vmcnt(0)" ::: "memory");
                    __hip_atomic_store((unsigned*)(ws + WS_FLAGS) + 64 * bhl, 1u, __ATOMIC_RELAXED, __HIP_MEMORY_SCOPE_AGENT); }
                __syncthreads();
            }
#endif
            pg8::Gemm g{(const bf16_t*)a.out, WPOOL, 1024, 256, 256, 0, 256, 0, 65536}; pg8::Order S; S.init(64, 1, 1, 4, G - 192, bid - 192);
            typedef pg8::EpiBf16<0, pg8::MapPool> E1; E1 E{pg8::MapPool{(bf16_t*)((unsigned char*)a.out + 32 * MiB)}, 1.f};
            if (PH(4)) pg8::gemm_phase<E1, true>(lds, g, S, E);
        }
        if (bid >= 64) {
            LAS float* scr = (LAS float*)(lds + wave * 16384);
            constexpr int I_SQ = 32 * 64, I_UP = 32 * 256, I_DN = 128 * 64, NIT = 2 * I_SQ + I_UP + I_DN;
            constexpr int NIT_A = NIT * 8 / 9;
            const bool kvb = bid < 192;
            for (int it = kvb ? (bid - 64) * 8 + wave : NIT_A + (bid - 192) * 8 + wave; it < (kvb ? NIT_A : NIT); it += (kvb ? 128 : 64) * 8) {
                int r = it;
                if (r < I_SQ) { p0_transpose_item(a.w_out, 2048, 0, 64, 2048, WOUT, 0, scr, r, lane); continue; } r -= I_SQ;
                if (r < I_SQ) { p0_transpose_item(a.xo_w, 2048, 0, 64, 2048, WO, 0, scr, r, lane); continue; } r -= I_SQ;
                if (r < I_UP) { p0_transpose_item(a.w_up, 8192, 0, 256, 2048, WUP, 0, scr, r, lane); continue; } r -= I_UP;
                p0_transpose_item(a.w_down, 2048, 0, 64, 8192, WDN, 0, scr, r, lane);
            }
            cvt_flat(a.xq_w, WQ, (size_t)DM * DM / 8, gtid - (size_t)64 * 512, (size_t)(G - 64) * 512);
        }
    }
    GRID_SYNC();

    {
        pg8::Gemm g{(const bf16_t*)((unsigned char*)a.out + 32 * MiB), WOUT, DM, DM, DM, (long)2048 * 2048, 0, 0, 0}; pg8::PanelOrder S; S.init(G, bid);
        typedef pg8::EpiLn2<false, false> E1; E1 E{HB, nullptr, nullptr, a.ln1_g, a.ln1_b, (unsigned long long*)(ws + WS_XCH), (unsigned*)(ws + WS_CTL + 16384)};
        if (PH(5)) pg8::gemm_phase<E1, true, pg8::PanelOrder>(lds, g, S, E);
    }
    {
        pg8::Gemm g{(const bf16_t*)((unsigned char*)a.out + 96 * MiB), WQ, DM, DM, 512, (long)256 * 2048, 512, 0, 512}; pg8::Order S; S.init(1, 8, 8, 4, G, bid);
        typedef pg8::EpiBf16<0, pg8::MapG> E1; E1 E{pg8::MapG{(bf16_t*)(ws + WS_G)}, 1.f};
        if (PH(6)) pg8::gemm_phase<E1, true>(lds, g, S, E);
    }
    {
        pg8::Gemm g{WO, (const bf16_t*)((unsigned char*)a.out + 104 * MiB), DM, DM, 512, 0, 512, (long)256 * 2048, 512}; pg8::Order S; S.init(8, 1, 8, 4, G, bid);
        typedef pg8::EpiBf16<0, pg8::MapVOT> E1; E1 E{pg8::MapVOT{(bf16_t*)(ws + WS_VOT)}, 1.f};
        if (PH(8)) pg8::gemm_phase<E1, true>(lds, g, S, E);
    }
    GRID_SYNC();

    {
        pg8::Gemm g{HB, (const bf16_t*)(ws + WS_G), DM, DM, DM, (long)2048 * 2048, 0, (long)4 * 256 * 2048, (long)256 * 2048}; pg8::Order S; S.init(8, 1, 8, 4, G, bid);
        pg8::EpiSoftmax E{(bf16_t*)(ws + WS_PR), 0.044194173824159216f * 1.4426950408889634f};
        if (G == 256 && PH(7)) pg8::gemm_phase<pg8::EpiSoftmax, false>(lds, g, S, E);
    }
    GRID_SYNC();
    {
        pg8::Gemm g{(const bf16_t*)(ws + WS_PR), (const bf16_t*)(ws + WS_VOT), 1024, 1024, 1024, (long)2048 * 1024, 0, (long)2048 * 1024, 0}; pg8::PanelOrder S; S.init(G, bid);
        typedef pg8::EpiLn2<false, false> E1; E1 E{HB, nullptr, nullptr, a.ln2_g, a.ln2_b, (unsigned long long*)(ws + WS_XCH) + (size_t)64 * 256 * 4, (unsigned*)(ws + WS_CTL + 2 * 16384)};
        if (PH(9)) pg8::gemm_phase<E1, true, pg8::PanelOrder>(lds, g, S, E);
    }
    GRID_SYNC();
    {
        pg8::Gemm g{HB, WUP, DM, DM, DM, 0, 0, 0, 0}; pg8::Order S; S.init(64, 32, 1, 1, G, bid);
        typedef pg8::EpiBf16<2, pg8::MapPlain> E1; E1 E{pg8::MapPlain{(bf16_t*)(ws + WS_HID), DFF}, 1.f};
        if (PH(10)) pg8::gemm_phase<E1, true>(lds, g, S, E);
    }
    GRID_SYNC();
    {
        pg8::Gemm g{(const bf16_t*)(ws + WS_HID), WDN, DFF, DFF, DFF, (long)2048 * DFF, 0, 0, 0}; pg8::PanelOrder S; S.init(G, bid);
        typedef pg8::EpiLn2<false, true> E1; E1 E{HB, nullptr, a.out, a.ln3_g, a.ln3_b, (unsigned long long*)(ws + WS_XCH) + (size_t)2 * 64 * 256 * 4, (unsigned*)(ws + WS_CTL + 3 * 16384)};
        if (PH(11)) pg8::gemm_phase<E1, true, pg8::PanelOrder>(lds, g, S, E);
    }
}

extern "C" void kernel_launch(void* const* d_in, const int* in_sizes, int n_in, void* d_out, int out_size, void* d_ws, size_t ws_size, hipStream_t stream) {
    static int grid = 0;
    if (grid == 0) {
        if (n_in != 22 || out_size != M_TOK * DM || ws_size < WS_END) { fprintf(stderr, "kernel_launch: unexpected problem (n_in %d out %d ws %zu)\n", n_in, out_size, ws_size); grid = -1; return; }
        int dev = 0, cus = 0, per_cu = 0;
        hipGetDevice(&dev); hipDeviceGetAttribute(&cus, hipDeviceAttributeMultiprocessorCount, dev);
        hipFuncSetAttribute((const void*)hybrid_fwd, hipFuncAttributeMaxDynamicSharedMemorySize, LDS_BYTES);
        hipOccupancyMaxActiveBlocksPerMultiprocessor(&per_cu, (const void*)hybrid_fwd, 512, LDS_BYTES);
        if (per_cu < 1) { fprintf(stderr, "kernel_launch: occupancy query says %d blocks per CU\n", per_cu); per_cu = 1; }
        grid = cus;
        if (grid > cus * per_cu) grid = cus * per_cu;
        (void)hipGetLastError();
    }
    if (grid < 0) return;
    if (hipMemsetAsync((char*)d_ws + WS_CTL, 0, CTL_BYTES, stream) != hipSuccess) { fprintf(stderr, "kernel_launch: memset failed\n"); return; }
    Args a{};
    const float** pa = (const float**)&a;
    for (int i = 0; i < 22; ++i) pa[i] = (const float*)d_in[i];
    a.out = (float*)d_out; a.ws = (unsigned char*)d_ws;
    void* args[] = {&a};
    hipError_t e = hipLaunchCooperativeKernel((const void*)hybrid_fwd, dim3(grid), dim3(512), args, LDS_BYTES, stream);
    if (e != hipSuccess) fprintf(stderr, "cooperative launch failed: %s (grid %d)\n", hipGetErrorString(e), grid);
}
```
